# Optimizing an MI355X kernel written in HIP

```python
import jax, jax.numpy as jnp
from jax import lax
import numpy as np

D_MODEL = 1024
BATCH = 8
SEQ = 4096
DEPTH = 4

N_EVEN = (DEPTH + 1) // 2
N_ODD = DEPTH // 2
D_PLE = 256
D_FF = 2816
EPS = 1e-6
N_NORMS = 5
NEG_BIG = -1e30
F_MIN = 1e-6
LB_MAX = 0.999

A_HEADS = 8
A_HEAD_DIM = 64
A_WIDTH = A_HEADS * A_HEAD_DIM
A_CHUNK = 128
B_HEADS = 4
B_KEY_DIM = 128
B_VAL_DIM = 128
B_KW = B_HEADS * B_KEY_DIM
B_VW = B_HEADS * B_VAL_DIM
B_CHUNK = 64
EVEN_IN = 2 * A_WIDTH + 2 * B_KW + 2 * B_VW
EVEN_OUT = A_WIDTH + B_VW
C_HEADS = 8
C_NOPE = 128
C_ROPE = 64
C_V = 128
C_QK = C_NOPE + C_ROPE
Q_LORA = 384
KV_LORA = 256
ODD_IN = Q_LORA + KV_LORA + C_ROPE
ATTN_BLOCK = 128
ROPE_THETA = 10000.0
ATTN_SCALE = C_QK ** -0.5

kernel_name = "hybrid_gmlp_hgrn2_mla_macaron_trunk"


def rms_norm(x, g):
    x32 = x.astype(jnp.float32)
    y = x32 * lax.rsqrt(jnp.mean(x32 * x32, axis=-1, keepdims=True) + EPS)
    return (y * g.astype(jnp.float32)).astype(x.dtype)


def swiglu(h, w_gate, w_up, w_down):
    return (jax.nn.silu(h @ w_gate) * (h @ w_up)) @ w_down


def gmlp_spatial(u, v, v_norm, w_s, b_s):
    bsz, seq = u.shape[:2]
    n_chunks = seq // A_CHUNK
    v = rms_norm(v, v_norm)
    vc = v.reshape(bsz, n_chunks, A_CHUNK, A_HEADS, A_HEAD_DIM)
    causal = jnp.tril(jnp.ones((A_CHUNK, A_CHUNK), dtype=bool))
    w = jnp.where(causal[None], w_s, 0.0).astype(vc.dtype)
    mixed = jnp.einsum('hts,bcshd->bcthd', w, vc) + b_s.T[None, None, :, :, None].astype(vc.dtype)
    return u * mixed.reshape(bsz, seq, A_HEADS, A_HEAD_DIM)


def hgrn2_chunkwise(q, log_f, k, v):
    bsz, seq = q.shape[:2]
    n = seq // B_CHUNK

    def to_chunks(t):
        t = t.astype(jnp.float32).reshape(bsz, n, B_CHUNK, B_HEADS, t.shape[-1])
        return jnp.transpose(t, (1, 0, 3, 2, 4))

    qc, kc, vc = to_chunks(q), to_chunks(k), to_chunks(v)
    bc = jnp.cumsum(to_chunks(log_f), axis=3)
    causal = jnp.tril(jnp.ones((B_CHUNK, B_CHUNK), dtype=bool))[:, :, None]

    def step(state, xs):
        q_, k_, v_, b_ = xs
        diff = b_[:, :, :, None, :] - b_[:, :, None, :, :]
        decay = jnp.exp(jnp.where(causal, diff, NEG_BIG))
        scores = jnp.einsum('bhtd,bhtsd->bhts', q_, decay * k_[:, :, None, :, :])
        o = jnp.einsum('bhts,bhse->bhte', scores, v_)
        o = o + jnp.einsum('bhtd,bhde->bhte', q_ * jnp.exp(b_), state)
        b_last = b_[:, :, -1:, :]
        state = jnp.exp(b_last)[:, :, 0, :, None] * state + jnp.einsum(
            'bhsd,bhse->bhde', k_ * jnp.exp(b_last - b_), v_)
        return state, o

    state0 = jnp.zeros((bsz, B_HEADS, B_KEY_DIM, B_VAL_DIM), jnp.float32)
    _, oc = lax.scan(step, state0, (qc, kc, vc, bc))
    return jnp.transpose(oc, (1, 0, 3, 2, 4)).reshape(bsz, seq, B_HEADS, B_VAL_DIM)


def even_mixer(h, w_in, v_norm, w_s, b_s, lb, out_norm, w_out):
    bsz, seq, _ = h.shape
    z = h @ w_in
    a_u, a_v, b_q, b_f, b_i, b_g = jnp.split(
        z, [A_WIDTH, 2 * A_WIDTH, 2 * A_WIDTH + B_KW, 2 * A_WIDTH + 2 * B_KW,
            2 * A_WIDTH + 2 * B_KW + B_VW], axis=-1)
    a_u = jax.nn.gelu(a_u).reshape(bsz, seq, A_HEADS, A_HEAD_DIM)
    a_v = jax.nn.gelu(a_v).reshape(bsz, seq, A_HEADS, A_HEAD_DIM)
    a_out = gmlp_spatial(a_u, a_v, v_norm, w_s, b_s).reshape(bsz, seq, A_WIDTH)
    zf = b_f.astype(jnp.float32)
    f = lb + (1.0 - lb) * jax.nn.sigmoid(zf)
    log_f = jnp.log(jnp.maximum(f, F_MIN))
    k = 1.0 - f
    o = hgrn2_chunkwise(b_q.reshape(bsz, seq, B_HEADS, B_KEY_DIM),
                        log_f.reshape(bsz, seq, B_HEADS, B_KEY_DIM),
                        k.reshape(bsz, seq, B_HEADS, B_KEY_DIM),
                        b_i.reshape(bsz, seq, B_HEADS, B_VAL_DIM))
    o = rms_norm(o, out_norm).astype(h.dtype) * jax.nn.silu(b_g.reshape(bsz, seq, B_HEADS, B_VAL_DIM))
    mixed = jnp.concatenate([a_out, o.reshape(bsz, seq, B_VW)], axis=-1)
    return mixed @ w_out


def rotate_half(x, cos, sin):
    x1, x2 = jnp.split(x, 2, axis=-1)
    return jnp.concatenate([x1 * cos - x2 * sin, x2 * cos + x1 * sin], axis=-1).astype(x.dtype)


def mla_mixer(h, positions, w_in, q_a_norm, kv_a_norm, w_q_b, w_kv_b, q_norm, k_norm, w_out):
    bsz, seq, _ = h.shape
    z = h @ w_in
    c_q, c_kv, k_rope = jnp.split(z, [Q_LORA, Q_LORA + KV_LORA], axis=-1)
    q = (rms_norm(c_q, q_a_norm) @ w_q_b).reshape(bsz, seq, C_HEADS, C_QK)
    kv = (rms_norm(c_kv, kv_a_norm) @ w_kv_b).reshape(bsz, seq, C_HEADS, C_NOPE + C_V)
    k_nope, v = jnp.split(kv, [C_NOPE], axis=-1)
    k_rope = jnp.broadcast_to(k_rope[:, :, None, :], (bsz, seq, C_HEADS, C_ROPE))
    k = jnp.concatenate([k_nope, k_rope], axis=-1)
    q = rms_norm(q, q_norm)
    k = rms_norm(k, k_norm)
    inv_freq = ROPE_THETA ** (-jnp.arange(0, C_ROPE, 2, dtype=jnp.float32) / C_ROPE)
    ang = positions.astype(jnp.float32)[..., None] * inv_freq
    cos = jnp.cos(ang)[:, :, None, :]
    sin = jnp.sin(ang)[:, :, None, :]
    q = jnp.concatenate([q[..., :C_NOPE], rotate_half(q[..., C_NOPE:], cos, sin)], axis=-1)
    k = jnp.concatenate([k[..., :C_NOPE], rotate_half(k[..., C_NOPE:], cos, sin)], axis=-1)
    q = jnp.transpose(q, (0, 2, 1, 3))
    k = jnp.transpose(k, (0, 2, 1, 3))
    v = jnp.transpose(v, (0, 2, 1, 3))
    n_blocks = seq // ATTN_BLOCK
    q_blocks = jnp.transpose(q.reshape(bsz, C_HEADS, n_blocks, ATTN_BLOCK, C_QK), (2, 0, 1, 3, 4))
    key_pos = jnp.arange(seq)

    def attend(args):
        qb, start = args
        s = jnp.einsum('bhqd,bhkd->bhqk', qb, k).astype(jnp.float32) * ATTN_SCALE
        q_pos = start + jnp.arange(ATTN_BLOCK)
        s = jnp.where(key_pos[None, :] <= q_pos[:, None], s, NEG_BIG)
        pr = jax.nn.softmax(s, axis=-1).astype(v.dtype)
        return jnp.einsum('bhqk,bhkd->bhqd', pr, v)

    out = lax.map(attend, (q_blocks, jnp.arange(n_blocks) * ATTN_BLOCK))
    out = jnp.transpose(out, (1, 0, 3, 2, 4)).reshape(bsz, seq, C_HEADS * C_V)
    return out @ w_out


def per_layer_embedding(h, p_i, w_gate, w_proj, post_norm):
    return rms_norm(jax.nn.sigmoid(h @ w_gate) * (p_i @ w_proj), post_norm)


def setup_inputs(seed: int = 0) -> dict:
    key = jax.random.key(seed)
    ks = jax.random.split(key, 32)
    f32 = jnp.float32

    def nrm(k, shape, fan_in):
        return jax.random.normal(k, shape, f32) * (fan_in ** -0.5)

    def gain(k, shape):
        return 1.0 + 0.02 * jax.random.normal(k, shape, f32)

    x = jax.random.normal(ks[0], (BATCH, SEQ, D_MODEL), f32)
    p = jax.random.normal(ks[1], (DEPTH, BATCH, SEQ, D_PLE), f32)
    offset = jax.random.randint(ks[2], (BATCH, 1), 0, 1024, dtype=jnp.int32)
    positions = offset + jnp.arange(SEQ, dtype=jnp.int32)[None, :]
    return {
        'x': x,
        'p': p,
        'positions': positions,
        'norm_gains': gain(ks[3], (DEPTH, N_NORMS, D_MODEL)),
        'ffn_w_gate': nrm(ks[4], (DEPTH, 2, D_MODEL, D_FF), D_MODEL),
        'ffn_w_up': nrm(ks[5], (DEPTH, 2, D_MODEL, D_FF), D_MODEL),
        'ffn_w_down': nrm(ks[6], (DEPTH, 2, D_FF, D_MODEL), D_FF),
        'ple_w_gate': nrm(ks[7], (DEPTH, D_MODEL, D_MODEL), D_MODEL),
        'ple_w_proj': nrm(ks[8], (DEPTH, D_PLE, D_MODEL), D_PLE),
        'even_w_in': nrm(ks[9], (N_EVEN, D_MODEL, EVEN_IN), D_MODEL),
        'gmlp_v_norm': gain(ks[10], (N_EVEN, A_HEADS, A_HEAD_DIM)),
        'gmlp_w_s': nrm(ks[11], (N_EVEN, A_HEADS, A_CHUNK, A_CHUNK), A_CHUNK),
        'gmlp_b_s': 1.0 + 0.01 * jax.random.normal(ks[12], (N_EVEN, A_HEADS, A_CHUNK), f32),
        'hgrn_lb_raw': 0.5 * jax.random.normal(ks[13], (N_EVEN, B_KW), f32),
        'hgrn_out_norm': gain(ks[14], (N_EVEN, B_VAL_DIM)),
        'even_w_out': nrm(ks[15], (N_EVEN, EVEN_OUT, D_MODEL), EVEN_OUT),
        'mla_w_in': nrm(ks[16], (N_ODD, D_MODEL, ODD_IN), D_MODEL),
        'mla_q_a_norm': gain(ks[17], (N_ODD, Q_LORA)),
        'mla_kv_a_norm': gain(ks[18], (N_ODD, KV_LORA)),
        'mla_w_q_b': nrm(ks[19], (N_ODD, Q_LORA, C_HEADS * C_QK), Q_LORA),
        'mla_w_kv_b': nrm(ks[20], (N_ODD, KV_LORA, C_HEADS * (C_NOPE + C_V)), KV_LORA),
        'mla_q_norm': gain(ks[21], (N_ODD, C_QK)),
        'mla_k_norm': gain(ks[22], (N_ODD, C_QK)),
        'mla_w_out': nrm(ks[23], (N_ODD, C_HEADS * C_V, D_MODEL), C_HEADS * C_V),
    }


def reference(x, p, positions, norm_gains, ffn_w_gate, ffn_w_up, ffn_w_down,
              ple_w_gate, ple_w_proj, even_w_in, gmlp_v_norm, gmlp_w_s, gmlp_b_s,
              hgrn_lb_raw, hgrn_out_norm, even_w_out, mla_w_in, mla_q_a_norm,
              mla_kv_a_norm, mla_w_q_b, mla_w_kv_b, mla_q_norm, mla_k_norm, mla_w_out):
    lb_sm = jax.nn.softmax(hgrn_lb_raw.astype(jnp.float32), axis=0)
    lower_bounds = jnp.clip(jnp.cumsum(lb_sm, axis=0) - lb_sm[0], 0.0, LB_MAX)
    for i in range(DEPTH):
        g = norm_gains[i]
        x = x + 0.5 * swiglu(rms_norm(x, g[0]), ffn_w_gate[i, 0], ffn_w_up[i, 0], ffn_w_down[i, 0])
        h = rms_norm(x, g[1])
        j = i // 2
        if i % 2 == 0:
            m = even_mixer(h, even_w_in[j], gmlp_v_norm[j], gmlp_w_s[j], gmlp_b_s[j],
                           lower_bounds[j], hgrn_out_norm[j], even_w_out[j])
        else:
            m = mla_mixer(h, positions, mla_w_in[j], mla_q_a_norm[j], mla_kv_a_norm[j],
                          mla_w_q_b[j], mla_w_kv_b[j], mla_q_norm[j], mla_k_norm[j], mla_w_out[j])
        x = x + m
        x = x + 0.5 * swiglu(rms_norm(x, g[2]), ffn_w_gate[i, 1], ffn_w_up[i, 1], ffn_w_down[i, 1])
        x = x + per_layer_embedding(rms_norm(x, g[3]), p[i], ple_w_gate[i], ple_w_proj[i], g[4])
    return x
```

```cpp
#include <hip/hip_runtime.h>
#include <hip/hip_cooperative_groups.h>
#include <cstdio>
#include <cstdint>
namespace cg = cooperative_groups;

#ifndef MK_SINGLE
#define MK_SINGLE 1
#endif
#ifndef EN
#define EN 0xffff
#ifndef PROBE_SYNC
#define PROBE_SYNC 0
#endif
#ifndef PROBE_HGRN
#define PROBE_HGRN 0
#endif
#ifndef PROBE_ATT
#define PROBE_ATT 0
#endif
#define VTEST 0
#define STQ 0.f
#define STK 0.f
#define STV 1.f
#endif

#define LAS __attribute__((address_space(3)))
typedef unsigned short bf16_t;
typedef short bf16x8 __attribute__((ext_vector_type(8)));
typedef float f32x4 __attribute__((ext_vector_type(4)));
typedef float f32x16 __attribute__((ext_vector_type(16)));
typedef unsigned u32x4 __attribute__((ext_vector_type(4)));
typedef unsigned u32x2 __attribute__((ext_vector_type(2)));
typedef short s16x4 __attribute__((ext_vector_type(4)));
typedef short v4i16_t __attribute__((ext_vector_type(4)));

constexpr int M = 32768, DM = 1024, SEQ = 4096, DFF = 2816, DEPTH = 4;
constexpr float EPS = 1e-6f;
constexpr int NSUB = 11, NPH = 1 + DEPTH * NSUB;

constexpr size_t MiB = 1u << 20;
constexpr size_t WS_SS = 576 * MiB;
constexpr size_t WS_LB = 3840 * 1024;
constexpr size_t WS_W = 4 * MiB;
constexpr size_t LW_STRIDE = 36 * MiB;
constexpr size_t OFF_WUP0 = 0, OFF_WUP1 = 11 * MiB, OFF_WDN0 = 22 * MiB, OFF_WDN1 = 22 * MiB + 5632 * 1024, OFF_WPG = 33 * MiB, OFF_WPP = 35 * MiB;
constexpr size_t WS_WE = 148 * MiB, WE_STRIDE = 8 * MiB, OFF_WEIN = 0, OFF_WEOUT = 6 * MiB;
constexpr size_t WS_WO = 164 * MiB, WO_STRIDE = 6 * MiB, OFF_WMIN = 0, OFF_WQB = 1536 * 1024, OFF_WKVB = 2816 * 1024, OFF_WMOUT = 3840 * 1024;
constexpr size_t WS_XB = 176 * MiB;
constexpr size_t WS_PB = 240 * MiB;
constexpr size_t WS_BIG = 256 * MiB;
constexpr size_t WS_ACT = WS_BIG;
constexpr size_t WS_PBUF = 432 * MiB;
constexpr size_t WS_TBUF = WS_BIG;
constexpr size_t WS_Z = WS_BIG;
constexpr size_t WS_LF = 416 * MiB;
constexpr size_t WS_MIX = 480 * MiB;
constexpr size_t WS_AO = WS_BIG;
constexpr size_t WS_ZC = WS_BIG;
constexpr size_t WS_Q = 320 * MiB;
constexpr size_t WS_KV = 416 * MiB;
constexpr size_t WS_OH = 544 * MiB;
constexpr size_t WS_VT = 512 * MiB;
constexpr size_t WS_END = 584 * MiB;

constexpr int LDS_BYTES = 147456;

typedef float f32x2_t __attribute__((ext_vector_type(2)));
typedef __bf16 bf16x2_t __attribute__((ext_vector_type(2)));
__device__ __forceinline__ unsigned cvt_pk(float lo, float hi) { f32x2_t v = {lo, hi}; bf16x2_t b = __builtin_convertvector(v, bf16x2_t); return __builtin_bit_cast(unsigned, b); }
__device__ __forceinline__ float bf_lo(unsigned w) { return __uint_as_float(w << 16); }
__device__ __forceinline__ float bf_hi(unsigned w) { return __uint_as_float(w & 0xffff0000u); }
__device__ __forceinline__ void unpack8(const u32x4 w, float* f) { f[0] = bf_lo(w.x); f[1] = bf_hi(w.x); f[2] = bf_lo(w.y); f[3] = bf_hi(w.y); f[4] = bf_lo(w.z); f[5] = bf_hi(w.z); f[6] = bf_lo(w.w); f[7] = bf_hi(w.w); }
__device__ __forceinline__ u32x4 pack8(const float* f) { u32x4 w; w.x = cvt_pk(f[0], f[1]); w.y = cvt_pk(f[2], f[3]); w.z = cvt_pk(f[4], f[5]); w.w = cvt_pk(f[6], f[7]); return w; }
__device__ __forceinline__ float fast_rcp(float x) { return __builtin_amdgcn_rcpf(x); }
__device__ __forceinline__ float sigmoidf_(float x) { return fast_rcp(1.f + __expf(-x)); }
__device__ __forceinline__ float siluf_(float x) { return x * sigmoidf_(x); }
__device__ __forceinline__ float gelu_tanh(float v) { const float t = 1.5957691216057308f * (v + 0.044715f * v * v * v); return v * sigmoidf_(t); }
__device__ __forceinline__ float wave_sum(float v) {
#pragma unroll
    for (int o = 1; o < 64; o <<= 1) v += __shfl_xor(v, o);
    return v;
}
__device__ __forceinline__ int rfl(int v) { return __builtin_amdgcn_readfirstlane(v); }
typedef unsigned long long ss_t;
__device__ __forceinline__ float ss_load(const ss_t* p, size_t row) { return (float)(long long)p[row] * (1.f / 1048576.f); }
__device__ __forceinline__ ss_t ss_fix(float v) { return (ss_t)(long long)__float2ll_rn(v * 1048576.f); }
__device__ __forceinline__ void ss_add(ss_t* p, size_t row, float v) { atomicAdd(p + row, ss_fix(v)); }
__device__ __forceinline__ float opaque_zero() { float z = 0.f; asm volatile("" : "+v"(z)); return z; }
__device__ __forceinline__ unsigned opaque_zero_u() { unsigned z = 0u; asm volatile("" : "+v"(z)); return z; }

namespace pg8 {
constexpr int BM = 256, BK = 64, HALF = 128, HTB = HALF * BK * 2, STAGE_BYTES = 8 * HTB, NXCD = 8, WGM = 8;
__host__ __device__ __forceinline__ int lds_byte(int r, int c) { const int st = (r >> 4) * 2 + (c >> 5), rr = r & 15, cc = c & 31, ob = rr * 64 + cc * 2; return st * 1024 + (ob ^ (((ob >> 9) & 1) << 5)); }
__host__ __device__ __forceinline__ void stage_rc(int b, int& R, int& C) { const int st = b / 1024, sb = b % 1024, swz = sb ^ (((sb >> 9) & 1) << 5); R = (st >> 1) * 16 + swz / 64; C = (st & 1) * 32 + (swz % 64) / 2; }
__host__ __device__ __forceinline__ int perm32(int rho) { const int n = rho >> 4, i = rho & 15; return 8 * (i >> 2) + 4 * n + (i & 3); }

struct Unit { int pm, pn; };
struct Gemm { const bf16_t* A; const bf16_t* Bt; int lda, ldb, M, N, K; };

struct StaticOrder {
    int nM, nN, nwg, G, c;
    __device__ void init(int M_, int N_, int G_, int c_) { nM = M_ / BM; nN = N_ / BM; nwg = nM * nN; G = G_; c = c_; }
    __device__ bool next(int i, Unit& u) const {
        const long L = (long)i * G + c; if (L >= nwg) return false;
        int wgid = (int)L; { const int q = nwg / NXCD, r = nwg % NXCD, xcd = wgid % NXCD, off = wgid / NXCD; wgid = (xcd < r ? xcd * (q + 1) : r * (q + 1) + (xcd - r) * q) + off; }
        const int nig = WGM * nN, gid = wgid / nig, fm = gid * WGM, gsz = (nM - fm) < WGM ? (nM - fm) : WGM;
        u.pm = fm + ((wgid % nig) % gsz); u.pn = (wgid % nig) / gsz; return true;
    }
};

template <int N_, int K_, int LDA, int LDB, class Epi>
__device__ __forceinline__ void gemm_phase(LAS unsigned char* lds, const bf16_t* gA, const bf16_t* gBt, int G, int tid, const Epi& E) {
    asm volatile("" : "+v"(tid));
    StaticOrder S; S.init(32768, N_, G, (int)blockIdx.x);
    const int wid = __builtin_amdgcn_readfirstlane(tid >> 6), lane = tid & 63, wr = wid >> 2, wc = wid & 3, fr = lane & 15, fq = lane >> 4;
    constexpr int K = K_, nt = K / BK;
    struct { const bf16_t* A; const bf16_t* Bt; int lda, ldb; } g{gA, gBt, LDA, LDB};
    unsigned voffA[2], voffB[2];
#pragma unroll
    for (int i = 0; i < 2; ++i) { int R, C; stage_rc(tid * 16 + i * 8192, R, C); const int Rb = (R & ~31) + perm32(R & 31);
        voffA[i] = (unsigned)(R * g.lda + C) * 2u; voffB[i] = (unsigned)(Rb * g.ldb + C) * 2u; }
    const size_t kstep = (size_t)(BK * 2);
    const size_t hstepA = (size_t)HALF * g.lda * 2, hstepB = (size_t)HALF * g.ldb * 2;
    const size_t tstepA = 2 * hstepA, tstepB = 2 * hstepB;
    const unsigned ldsw = (unsigned)wid * 1024u;
    const int aoff = lds_byte(wr * 64 + fr, fq * 8), boff = lds_byte(wc * 32 + fr, fq * 8);
#define PG8_SA(b, h) (((b) * 2 + (h)) * HTB)
#define PG8_SB(b, h) ((4 + (b) * 2 + (h)) * HTB)
#define PG8_STAGE(bufoff, gbase, voff) do { _Pragma("unroll") for (int _i = 0; _i < 2; ++_i) \
        __builtin_amdgcn_global_load_lds((const unsigned*)((const char*)(gbase) + (voff)[_i]), (LAS unsigned*)(lds + (bufoff) + ldsw + _i * 8192), 16, 0, 0); } while (0)
#define PG8_LDA(dst, b, h) do { _Pragma("unroll") for (int m = 0; m < 4; ++m) _Pragma("unroll") for (int k = 0; k < 2; ++k) dst[m][k] = *(const LAS bf16x8*)(lds + PG8_SA(b, h) + aoff + m * 2048 + k * 1024); } while (0)
#define PG8_LDB(dst, b, h) do { _Pragma("unroll") for (int n = 0; n < 2; ++n) _Pragma("unroll") for (int k = 0; k < 2; ++k) dst[n][k] = *(const LAS bf16x8*)(lds + PG8_SB(b, h) + boff + n * 2048 + k * 1024); } while (0)
#define PG8_MMA(ai, bj, At, Bt) do { __builtin_amdgcn_s_setprio(1); _Pragma("unroll") for (int m = 0; m < 4; ++m) _Pragma("unroll") for (int n = 0; n < 2; ++n) _Pragma("unroll") for (int k = 0; k < 2; ++k) \
        acc[ai][bj][m][n] = __builtin_amdgcn_mfma_f32_16x16x32_bf16(Bt[n][k], At[m][k], acc[ai][bj][m][n], 0, 0, 0); __builtin_amdgcn_s_setprio(0); } while (0)
#define PG8_WAIT_V(n) asm volatile("s_waitcnt vmcnt(" #n ")" ::: "memory")
#define PG8_WAIT_L(n) asm volatile("s_waitcnt lgkmcnt(" #n ")" ::: "memory")
#define PG8_BAR __builtin_amdgcn_s_barrier()
#define PG8_SCHED __builtin_amdgcn_sched_barrier(0)
    Unit cur, nxt; int ui = 0;
    if (!S.next(0, cur)) return;
    const float zf = opaque_zero();
    f32x4 acc[2][2][4][2];
#pragma unroll
    for (int a = 0; a < 2; ++a)
#pragma unroll
        for (int b = 0; b < 2; ++b)
#pragma unroll
            for (int m = 0; m < 4; ++m)
#pragma unroll
                for (int n = 0; n < 2; ++n) acc[a][b][m][n] = (f32x4){zf, zf, zf, zf};
    bf16x8 At[4][2], B0[2][2], B1[2][2];
    const char* cA = (const char*)g.A + (size_t)cur.pm * tstepA; const char* cB = (const char*)g.Bt + (size_t)cur.pn * tstepB;
    PG8_STAGE(PG8_SB(0, 0), cB, voffB); PG8_STAGE(PG8_SB(0, 1), cB + hstepB, voffB); PG8_STAGE(PG8_SA(0, 0), cA, voffA); PG8_STAGE(PG8_SA(0, 1), cA + hstepA, voffA);
    if (wr == 1) PG8_BAR;
    PG8_WAIT_V(2); PG8_BAR;
    PG8_STAGE(PG8_SB(1, 0), cB + kstep, voffB); PG8_STAGE(PG8_SA(1, 0), cA + kstep, voffA); PG8_STAGE(PG8_SB(1, 1), cB + hstepB + kstep, voffB);
    PG8_WAIT_V(6); PG8_BAR;
    for (;;) {
        const bool has_next = S.next(ui + 1, nxt);
        const char* nA = has_next ? (const char*)g.A + (size_t)nxt.pm * tstepA : cA; const char* nB = has_next ? (const char*)g.Bt + (size_t)nxt.pn * tstepB : cB;
#pragma unroll 1
        for (int t = 0; t < nt; t += 2) {
            const bool last = (t == nt - 2);
            const char* a1 = cA + (size_t)(t + 1) * kstep;
            const char* a2 = last ? nA : cA + (size_t)(t + 2) * kstep; const char* b2 = last ? nB : cB + (size_t)(t + 2) * kstep;
            const char* a3 = a2 + kstep; const char* b3 = b2 + kstep;
            PG8_LDB(B0, 0, 0); PG8_LDB(B1, 0, 1); PG8_SCHED; PG8_LDA(At, 0, 0); PG8_STAGE(PG8_SA(1, 1), a1 + hstepA, voffA);
            PG8_WAIT_V(8); PG8_WAIT_L(0); PG8_BAR; PG8_MMA(0, 0, At, B0); PG8_MMA(0, 1, At, B1); PG8_BAR; PG8_SCHED;
            PG8_LDA(At, 0, 1); PG8_STAGE(PG8_SB(0, 0), b2, voffB); PG8_STAGE(PG8_SB(0, 1), b2 + hstepB, voffB); PG8_STAGE(PG8_SA(0, 0), a2, voffA);
            PG8_WAIT_V(8); PG8_WAIT_L(0); PG8_BAR; PG8_MMA(1, 0, At, B0); PG8_MMA(1, 1, At, B1); PG8_BAR; PG8_SCHED;
            PG8_LDB(B0, 1, 0); PG8_LDB(B1, 1, 1); PG8_SCHED; PG8_LDA(At, 1, 0); PG8_STAGE(PG8_SA(0, 1), a2 + hstepA, voffA);
            PG8_WAIT_V(8); PG8_WAIT_L(0); PG8_BAR; PG8_MMA(0, 0, At, B0); PG8_MMA(0, 1, At, B1); PG8_BAR; PG8_SCHED;
            PG8_LDA(At, 1, 1); PG8_STAGE(PG8_SB(1, 0), b3, voffB); PG8_STAGE(PG8_SB(1, 1), b3 + hstepB, voffB); PG8_STAGE(PG8_SA(1, 0), a3, voffA);
            PG8_WAIT_V(8); PG8_WAIT_L(0); PG8_BAR; PG8_MMA(1, 0, At, B0); PG8_MMA(1, 1, At, B1); PG8_BAR; PG8_SCHED;
        }
        if (wr == 0) PG8_BAR;
        E(acc, cur, wr, wc, fr, fq);
        if (!has_next) break;
#pragma unroll
        for (int a = 0; a < 2; ++a)
#pragma unroll
            for (int b = 0; b < 2; ++b)
#pragma unroll
                for (int m = 0; m < 4; ++m)
#pragma unroll
                    for (int n = 0; n < 2; ++n) acc[a][b][m][n] = (f32x4){zf, zf, zf, zf};
        cur = nxt; cA = nA; cB = nB; ++ui;
        if (wr == 1) PG8_BAR;
    }
    PG8_WAIT_V(0);
    PG8_BAR;
#undef PG8_SA
#undef PG8_SB
#undef PG8_STAGE
#undef PG8_LDA
#undef PG8_LDB
#undef PG8_MMA
#undef PG8_WAIT_V
#undef PG8_WAIT_L
#undef PG8_BAR
#undef PG8_SCHED
}

typedef f32x4 AccT[2][2][4][2];

struct EpiUp {
    bf16_t* O; const ss_t* ss;
    __device__ __forceinline__ void operator()(const AccT& acc, const Unit& u, int wr, int wc, int fr, int fq) const {
        const int row0 = u.pm * BM + wr * 64 + fr, col0 = u.pn * 128 + wc * 32 + 8 * fq;
        ss_t sv[8];
#pragma unroll
        for (int gi = 0; gi < 8; ++gi) sv[gi] = ss[row0 + (gi >> 2) * HALF + (gi & 3) * 16];
#pragma unroll
        for (int gi = 0; gi < 8; ++gi) {
            const int ai = gi >> 2, m = gi & 3;
            const int row = row0 + ai * HALF + m * 16;
            const float rs = rsqrtf((float)(long long)sv[gi] * (1.f / 1048576.f) * (1.f / 1024.f) + EPS);
            float o[8];
#pragma unroll
            for (int n = 0; n < 2; ++n)
#pragma unroll
                for (int e = 0; e < 4; ++e) { const float gv = acc[ai][0][m][n][e] * rs, uv = acc[ai][1][m][n][e] * rs; o[4 * n + e] = siluf_(gv) * uv; }
            *(u32x4*)(O + (size_t)row * DFF + col0) = pack8(o);
        }
    }
};
struct EpiResid {
    bf16_t* xb; ss_t* ss_out; float alpha;
    __device__ __forceinline__ void operator()(const AccT& acc, const Unit& u, int wr, int wc, int fr, int fq) const {
        const int row0 = u.pm * BM + wr * 64 + fr, col0 = u.pn * BM + wc * 32 + 8 * fq;
        u32x4 cur[2], nxt[2];
#pragma unroll
        for (int bj = 0; bj < 2; ++bj) cur[bj] = *(const u32x4*)(xb + (size_t)row0 * DM + col0 + bj * HALF);
#pragma unroll
        for (int gi = 0; gi < 8; ++gi) {
            const int ai = gi >> 2, m = gi & 3;
            const int row = row0 + ai * HALF + m * 16; float ssp = 0.f;
            if (gi + 1 < 8) { const int rown = row0 + ((gi + 1) >> 2) * HALF + ((gi + 1) & 3) * 16;
#pragma unroll
                for (int bj = 0; bj < 2; ++bj) nxt[bj] = *(const u32x4*)(xb + (size_t)rown * DM + col0 + bj * HALF); }
#pragma unroll
            for (int bj = 0; bj < 2; ++bj) {
                const size_t off = (size_t)row * DM + col0 + bj * HALF;
                float b[8]; unpack8(cur[bj], b);
                float v[8];
#pragma unroll
                for (int e = 0; e < 4; ++e) { v[e] = b[e] + acc[ai][bj][m][0][e] * alpha; v[4 + e] = b[4 + e] + acc[ai][bj][m][1][e] * alpha; }
                *(u32x4*)(xb + off) = pack8(v);
#pragma unroll
                for (int e = 0; e < 8; ++e) ssp += v[e] * v[e];
            }
            ssp += __shfl_xor(ssp, 16); ssp += __shfl_xor(ssp, 32);
            if (fq == 0) ss_add(ss_out, row, ssp);
            cur[0] = nxt[0]; cur[1] = nxt[1];
        }
    }
};
struct EpiScale {
    bf16_t* O; int ldc; const ss_t* ss_in; float inv_n; ss_t* ss_o0; ss_t* ss_o1; int sscode;
    __device__ __forceinline__ void operator()(const AccT& acc, const Unit& u, int wr, int wc, int fr, int fq) const {
        const int row0 = u.pm * BM + wr * 64 + fr, col0 = u.pn * BM + wc * 32 + 8 * fq;
        ss_t sv[8];
#pragma unroll
        for (int gi = 0; gi < 8; ++gi) sv[gi] = ss_in ? ss_in[row0 + (gi >> 2) * HALF + (gi & 3) * 16] : (ss_t)0;
#pragma unroll
        for (int ai = 0; ai < 2; ++ai)
#pragma unroll
            for (int m = 0; m < 4; ++m) {
                const int row = row0 + ai * HALF + m * 16;
                const float rs = ss_in ? rsqrtf((float)(long long)sv[ai * 4 + m] * (1.f / 1048576.f) * inv_n + EPS) : 1.f;
#pragma unroll
                for (int bj = 0; bj < 2; ++bj) {
                    const f32x4 v0 = acc[ai][bj][m][0] * rs, v1 = acc[ai][bj][m][1] * rs;
                    u32x4 w; w.x = cvt_pk(v0[0], v0[1]); w.y = cvt_pk(v0[2], v0[3]); w.z = cvt_pk(v1[0], v1[1]); w.w = cvt_pk(v1[2], v1[3]);
                    *(u32x4*)(O + (size_t)row * ldc + col0 + bj * HALF) = w;
                    const int code = (sscode >> (2 * (u.pn * 2 + bj))) & 3;
                    if (code) {
                        float ssp = (v0[0] * v0[0] + v0[1] * v0[1]) + (v0[2] * v0[2] + v0[3] * v0[3]) + (v1[0] * v1[0] + v1[1] * v1[1]) + (v1[2] * v1[2] + v1[3] * v1[3]);
                        ssp += __shfl_xor(ssp, 16); ssp += __shfl_xor(ssp, 32);
                        if (fq == 0) ss_add(code == 1 ? ss_o0 : ss_o1, row, ssp);
                    }
                }
            }
    }
};
struct EpiKV {
    bf16_t* KB; bf16_t* VT; const ss_t* ss_in;
    __device__ __forceinline__ void operator()(const AccT& acc, const Unit& u, int wr, int wc, int fr, int fq) const {
        const int row0 = u.pm * BM + wr * 64 + fr, c0 = wc * 32 + 8 * fq;
#pragma unroll
        for (int ai = 0; ai < 2; ++ai)
#pragma unroll
            for (int m = 0; m < 4; ++m) {
                const int row = row0 + ai * HALF + m * 16;
                {
                    const f32x4 v0 = acc[ai][0][m][0], v1 = acc[ai][0][m][1];
                    u32x4 w; w.x = cvt_pk(v0[0], v0[1]); w.y = cvt_pk(v0[2], v0[3]); w.z = cvt_pk(v1[0], v1[1]); w.w = cvt_pk(v1[2], v1[3]);
                    *(u32x4*)(KB + (size_t)row * 1536 + u.pn * 192 + c0) = w;
                }
                {
                    const f32x4 v0 = acc[ai][1][m][0], v1 = acc[ai][1][m][1];
                    const unsigned w[4] = {cvt_pk(v0[0], v0[1]), cvt_pk(v0[2], v0[3]), cvt_pk(v1[0], v1[1]), cvt_pk(v1[2], v1[3])};
                    { u32x4 ww; ww.x = w[0]; ww.y = w[1]; ww.z = w[2]; ww.w = w[3]; *(u32x4*)(VT + (size_t)row * 1024 + u.pn * 128 + c0) = ww; }
                }
            }
    }
};
struct EpiEvenIn {
    bf16_t* Z; float* LF; const ss_t* ss; const float* lb;
    __device__ __forceinline__ void operator()(const AccT& acc, const Unit& u, int wr, int wc, int fr, int fq) const {
        const int row0 = u.pm * BM + wr * 64 + fr, col0 = u.pn * BM + wc * 32 + 8 * fq;
        const int kind = u.pn >> 1;
        ss_t sv[8];
#pragma unroll
        for (int gi = 0; gi < 8; ++gi) sv[gi] = ss[row0 + (gi >> 2) * HALF + (gi & 3) * 16];
#pragma unroll
        for (int ai = 0; ai < 2; ++ai)
#pragma unroll
            for (int m = 0; m < 4; ++m) {
                const int row = row0 + ai * HALF + m * 16;
                const float rs = rsqrtf((float)(long long)sv[ai * 4 + m] * (1.f / 1048576.f) * (1.f / 1024.f) + EPS);
#pragma unroll
                for (int bj = 0; bj < 2; ++bj) {
                    const int col = col0 + bj * HALF;
                    float v[8];
#pragma unroll
                    for (int e = 0; e < 4; ++e) { v[e] = acc[ai][bj][m][0][e] * rs; v[4 + e] = acc[ai][bj][m][1][e] * rs; }
                    if (kind == 3) {
                        const int cf = col - 1536;
                        f32x4 l0, l1;
#pragma unroll
                        for (int e = 0; e < 8; ++e) { const float lbv = lb[cf + e]; const float f = lbv + (1.f - lbv) * sigmoidf_(v[e]); const float lf = __logf(fmaxf(f, 1e-6f)); if (e < 4) l0[e] = lf; else l1[e - 4] = lf; }
                        *(f32x4*)(LF + (size_t)row * 512 + cf) = l0; *(f32x4*)(LF + (size_t)row * 512 + cf + 4) = l1;
                    } else {
                        if (kind <= 1) {
#pragma unroll
                            for (int e = 0; e < 8; ++e) v[e] = gelu_tanh(v[e]);
                        } else if (kind == 5) {
#pragma unroll
                            for (int e = 0; e < 8; ++e) v[e] = siluf_(v[e]);
                        }
                        const int dc = kind >= 4 ? col - 512 : col;
                        *(u32x4*)(Z + (size_t)row * 2560 + dc) = pack8(v);
                    }
                }
            }
    }
};
struct EpiPleG {
    const bf16_t* P; bf16_t* T; const ss_t* ss; ss_t* tss;
    __device__ __forceinline__ void operator()(const AccT& acc, const Unit& u, int wr, int wc, int fr, int fq) const {
        const int row0 = u.pm * BM + wr * 64 + fr, col0 = u.pn * BM + wc * 32 + 8 * fq;
        ss_t sv[8];
#pragma unroll
        for (int gi = 0; gi < 8; ++gi) sv[gi] = ss[row0 + (gi >> 2) * HALF + (gi & 3) * 16];
        u32x4 cur[2], nxt[2];
#pragma unroll
        for (int bj = 0; bj < 2; ++bj) cur[bj] = *(const u32x4*)(P + (size_t)row0 * DM + col0 + bj * HALF);
#pragma unroll
        for (int gi = 0; gi < 8; ++gi) {
            const int ai = gi >> 2, m = gi & 3;
            const int row = row0 + ai * HALF + m * 16; float ssp = 0.f;
            if (gi + 1 < 8) { const int rown = row0 + ((gi + 1) >> 2) * HALF + ((gi + 1) & 3) * 16;
#pragma unroll
                for (int bj = 0; bj < 2; ++bj) nxt[bj] = *(const u32x4*)(P + (size_t)rown * DM + col0 + bj * HALF); }
            const float rs = rsqrtf((float)(long long)sv[gi] * (1.f / 1048576.f) * (1.f / 1024.f) + EPS);
#pragma unroll
            for (int bj = 0; bj < 2; ++bj) {
                const size_t off = (size_t)row * DM + col0 + bj * HALF;
                float pv[8]; unpack8(cur[bj], pv);
                float t[8];
#pragma unroll
                for (int e = 0; e < 4; ++e) { t[e] = sigmoidf_(acc[ai][bj][m][0][e] * rs) * pv[e]; t[4 + e] = sigmoidf_(acc[ai][bj][m][1][e] * rs) * pv[4 + e]; }
#pragma unroll
                for (int e = 0; e < 8; ++e) ssp += t[e] * t[e];
                *(u32x4*)(T + off) = pack8(t);
            }
            ssp += __shfl_xor(ssp, 16); ssp += __shfl_xor(ssp, 32);
            if (fq == 0) ss_add(tss, row, ssp);
            cur[0] = nxt[0]; cur[1] = nxt[1];
        }
    }
};
}

struct Args { const void* in[24]; float* out; unsigned char* ws; int ph_lo, ph_hi; };


__device__ __forceinline__ void tr_item(const float* __restrict__ W, int ldw, int col0, int k0, const float* __restrict__ gain, bf16_t* WT, int ldt, int drow0, bool zero, LAS float* scr, int lane) {
    const int c = lane & 7;
    if (zero) {
#pragma unroll
        for (int j = 0; j < 4; ++j) { const int n = (lane >> 3) + 8 * j; const unsigned zu = opaque_zero_u(); *(u32x4*)(WT + (size_t)(drow0 + n) * ldt + k0 + 8 * c) = (u32x4){zu, zu, zu, zu}; }
        return;
    }
    float wv[32];
    const float* wp = W + (size_t)(k0 + (lane >> 5)) * ldw + col0 + (lane & 31);
#pragma unroll
    for (int i = 0; i < 32; ++i) wv[i] = wp[(size_t)(2 * i) * ldw];
    const float gl = gain ? gain[k0 + lane] : 1.f;
#pragma unroll
    for (int i = 0; i < 32; ++i) { const int kk = 2 * i + (lane >> 5); scr[kk * 33 + (lane & 31)] = wv[i] * __shfl(gl, kk); }
    asm volatile("s_waitcnt lgkmcnt(0)" ::: "memory");
#pragma unroll
    for (int j = 0; j < 4; ++j) { const int n = (lane >> 3) + 8 * j; const LAS float* s = scr + (8 * c) * 33 + n;
        u32x4 o; o.x = cvt_pk(s[0 * 33], s[1 * 33]); o.y = cvt_pk(s[2 * 33], s[3 * 33]); o.z = cvt_pk(s[4 * 33], s[5 * 33]); o.w = cvt_pk(s[6 * 33], s[7 * 33]);
        *(u32x4*)(WT + (size_t)(drow0 + n) * ldt + k0 + 8 * c) = o; }
    asm volatile("s_waitcnt lgkmcnt(0)" ::: "memory");
}

__device__ __forceinline__ void p0_prologue(const Args& a, LAS unsigned char* lds, int tid, int lane, int wave, int G, int bx, size_t zo) {
    unsigned char* ws = a.ws + zo;
    LAS float* scr = (LAS float*)(lds + wave * 8704);
    const int gw = blockIdx.x * 8 + wave, NGW = G * 8;
    const float* ng = (const float*)a.in[3];
    constexpr int L_ITEMS = 9088, N_L = 4 * L_ITEMS, E_ITEMS = 2048, O_ITEMS = 1440, NITEMS = N_L + 2 * E_ITEMS + 2 * O_ITEMS;
    for (int it0 = gw; it0 < NITEMS; it0 += NGW) {
        int it = it0;
        const float* W; int ldw, col0, k0, ldt, drow0; const float* gain = nullptr; bf16_t* WT; bool zero = false;
        if (it < N_L) {
            const int i = it / L_ITEMS; int r = it % L_ITEMS; unsigned char* wl = ws + WS_W + (size_t)i * LW_STRIDE;
            if (r < 8448) {
                const int f = r / 4224; r %= 4224;
                if (r < 2816) { const int kb = r / 176, nb = r % 176, tile = nb >> 3, cb = nb & 7;
                    W = (const float*)a.in[cb < 4 ? 4 : 5] + (size_t)(i * 2 + f) * DM * DFF; ldw = DFF; col0 = tile * 128 + (cb & 3) * 32; k0 = kb * 64;
                    gain = ng + (i * 5 + (f ? 2 : 0)) * 1024; WT = (bf16_t*)(wl + (f ? OFF_WUP1 : OFF_WUP0)); ldt = 1024; drow0 = nb * 32;
                } else { r -= 2816; const int kb = r / 32, nb = r % 32;
                    W = (const float*)a.in[6] + (size_t)(i * 2 + f) * DFF * DM; ldw = DM; col0 = nb * 32; k0 = kb * 64; WT = (bf16_t*)(wl + (f ? OFF_WDN1 : OFF_WDN0)); ldt = DFF; drow0 = nb * 32; }
            } else { r -= 8448;
                if (r < 512) { const int kb = r / 32, nb = r % 32; W = (const float*)a.in[7] + (size_t)i * DM * DM; ldw = DM; col0 = nb * 32; k0 = kb * 64; gain = ng + (i * 5 + 3) * 1024; WT = (bf16_t*)(wl + OFF_WPG); ldt = 1024; drow0 = nb * 32; }
                else { r -= 512; const int kb = r / 32, nb = r % 32; W = (const float*)a.in[8] + (size_t)i * 256 * DM; ldw = DM; col0 = nb * 32; k0 = kb * 64; WT = (bf16_t*)(wl + OFF_WPP); ldt = 256; drow0 = nb * 32; }
            }
        } else {
            it -= N_L;
            if (it < 2 * E_ITEMS) { const int j = it / E_ITEMS; int r = it % E_ITEMS; unsigned char* we = ws + WS_WE + (size_t)j * WE_STRIDE;
                if (r < 1536) { const int kb = r / 96, nb = r % 96; W = (const float*)a.in[9] + (size_t)j * DM * 3072; ldw = 3072; col0 = nb * 32; k0 = kb * 64; gain = ng + ((2 * j) * 5 + 1) * 1024; WT = (bf16_t*)(we + OFF_WEIN); ldt = 1024; drow0 = nb * 32; }
                else { r -= 1536; const int kb = r / 32, nb = r % 32; W = (const float*)a.in[15] + (size_t)j * DM * DM; ldw = DM; col0 = nb * 32; k0 = kb * 64; WT = (bf16_t*)(we + OFF_WEOUT); ldt = 1024; drow0 = nb * 32; }
            } else { it -= 2 * E_ITEMS; const int j = it / O_ITEMS; int r = it % O_ITEMS; unsigned char* wo = ws + WS_WO + (size_t)j * WO_STRIDE;
                if (r < 384) { const int kb = r / 24, nb = r % 24; zero = nb >= 22; W = (const float*)a.in[16] + (size_t)j * DM * 704; ldw = 704; col0 = nb * 32; k0 = kb * 64; gain = ng + ((2 * j + 1) * 5 + 1) * 1024; WT = (bf16_t*)(wo + OFF_WMIN); ldt = 1024; drow0 = nb * 32; }
                else if ((r -= 384) < 288) { const int kb = r / 48, nb = r % 48; W = (const float*)a.in[19] + (size_t)j * 384 * 1536; ldw = 1536; col0 = nb * 32; k0 = kb * 64; gain = (const float*)a.in[17] + j * 384; WT = (bf16_t*)(wo + OFF_WQB); ldt = 384; drow0 = nb * 32; }
                else if ((r -= 288) < 256) { const int kb = r / 64, nb = r % 64; W = (const float*)a.in[20] + (size_t)j * 256 * 2048; ldw = 2048; col0 = nb * 32; k0 = kb * 64; gain = (const float*)a.in[18] + j * 256; WT = (bf16_t*)(wo + OFF_WKVB); ldt = 256; drow0 = nb * 32; }
                else { r -= 256; const int kb = r / 32, nb = r % 32; W = (const float*)a.in[23] + (size_t)j * DM * DM; ldw = DM; col0 = nb * 32; k0 = kb * 64; WT = (bf16_t*)(wo + OFF_WMOUT); ldt = 1024; drow0 = nb * 32; }
            }
        }
        tr_item(W, ldw, col0, k0, gain, WT, ldt, drow0, zero, scr, lane);
    }
    {
        const float* x = (const float*)a.in[0]; bf16_t* XB = (bf16_t*)(ws + WS_XB); ss_t* SS = (ss_t*)(ws + WS_SS);
        for (int row = gw; row < M; row += NGW) {
            float ssp = 0.f;
#pragma unroll
            for (int j = 0; j < 2; ++j) { const int c = lane + 64 * j; const size_t off = (size_t)row * DM + 8 * c;
                const f32x4 v0 = *(const f32x4*)(x + off), v1 = *(const f32x4*)(x + off + 4);
                u32x4 w; w.x = cvt_pk(v0[0], v0[1]); w.y = cvt_pk(v0[2], v0[3]); w.z = cvt_pk(v1[0], v1[1]); w.w = cvt_pk(v1[2], v1[3]);
                *(u32x4*)(XB + off) = w;
                ssp += (v0[0] * v0[0] + v0[1] * v0[1]) + (v0[2] * v0[2] + v0[3] * v0[3]) + (v1[0] * v1[0] + v1[1] * v1[1]) + (v1[2] * v1[2] + v1[3] * v1[3]); }
            ssp = wave_sum(ssp);
            if (lane == 0) SS[row] = ss_fix(ssp);
        }
        f32x4* z = (f32x4*)(SS + M);
        for (size_t i = (size_t)blockIdx.x * 512 + tid; i < (size_t)28 * M / 2; i += (size_t)G * 512) { const float zz = opaque_zero(); z[i] = (f32x4){zz, zz, zz, zz}; }
        if (blockIdx.x == 0) { const float* lr = (const float*)a.in[13]; float* LB = (float*)(ws + WS_LB);
            const float r0 = lr[tid], r1 = lr[512 + tid]; const float sm1 = 1.f / (1.f + expf(r0 - r1));
            LB[tid] = 0.f; LB[512 + tid] = fminf(fmaxf(sm1, 0.f), 0.999f); }
    }
}

__device__ __forceinline__ void p_convert(const float* p, bf16_t* PB, int tid, int G) {
    for (size_t i = (size_t)blockIdx.x * 512 + tid; i < (size_t)M * 256 / 8; i += (size_t)G * 512) {
        const f32x4 v0 = *(const f32x4*)(p + i * 8), v1 = *(const f32x4*)(p + i * 8 + 4);
        u32x4 w; w.x = cvt_pk(v0[0], v0[1]); w.y = cvt_pk(v0[2], v0[3]); w.z = cvt_pk(v1[0], v1[1]); w.w = cvt_pk(v1[2], v1[3]);
        *(u32x4*)(PB + i * 8) = w;
    }
}
__device__ __forceinline__ void ple_finalize(float* xout, const bf16_t* T, const ss_t* tss, const float* g4, bf16_t* XB, ss_t* ssn, int lane, int wave, int G) {
    const int gw = blockIdx.x * 8 + wave, NGW = G * 8;
    f32x4 gg[2][2];
#pragma unroll
    for (int j = 0; j < 2; ++j) { const int c = lane + 64 * j; gg[j][0] = *(const f32x4*)(g4 + 8 * c); gg[j][1] = *(const f32x4*)(g4 + 8 * c + 4); }
    for (int row = gw; row < M; row += 2 * NGW) {
        u32x4 tv[2][2], xv[2][2]; ss_t sv[2];
#pragma unroll
        for (int r = 0; r < 2; ++r) { const int rr = row + r * NGW; sv[r] = tss[rr];
#pragma unroll
            for (int j = 0; j < 2; ++j) { const int c = lane + 64 * j; const size_t off = (size_t)rr * DM + 8 * c; tv[r][j] = *(const u32x4*)(T + off); xv[r][j] = *(const u32x4*)(XB + off); } }
#pragma unroll
        for (int r = 0; r < 2; ++r) { const int rr = row + r * NGW;
            const float rs = rsqrtf((float)(long long)sv[r] * (1.f / 1048576.f) * (1.f / 1024.f) + EPS); float ssp = 0.f;
#pragma unroll
            for (int j = 0; j < 2; ++j) { const int c = lane + 64 * j; const size_t off = (size_t)rr * DM + 8 * c;
                float t[8], v[8]; unpack8(tv[r][j], t); unpack8(xv[r][j], v);
#pragma unroll
                for (int e = 0; e < 4; ++e) { v[e] += t[e] * rs * gg[j][0][e]; v[4 + e] += t[4 + e] * rs * gg[j][1][e]; }
                if (xout) { *(f32x4*)(xout + off) = (f32x4){v[0], v[1], v[2], v[3]}; *(f32x4*)(xout + off + 4) = (f32x4){v[4], v[5], v[6], v[7]}; }
                *(u32x4*)(XB + off) = pack8(v);
#pragma unroll
                for (int e = 0; e < 8; ++e) ssp += v[e] * v[e]; }
            ssp = wave_sum(ssp);
            if (lane == 0) ssn[rr] = ss_fix(ssp); }
    }
}

__device__ __forceinline__ void gmlp_unit(LAS unsigned char* lds, int unit, const bf16_t* Z, const float* w_s, const float* b_s, const float* vnorm, bf16_t* MIX, int tid, bool stage_w) {
    asm volatile("" : "+v"(tid));
    const int h = unit & 7, bc = unit >> 3;
    const size_t row0 = (size_t)bc * 128;
    LAS bf16_t* Wb = (LAS bf16_t*)lds;
    LAS bf16_t* VnT = (LAS bf16_t*)(lds + 34816);
    const int lane = tid & 63, wave = rfl(tid >> 6), fr = lane & 15, fq = lane >> 4;
    {
        const int s = tid >> 2, part = tid & 3;
        const bf16_t* vp = Z + (row0 + s) * 2560 + 512 + h * 64 + part * 16;
        float v[16]; unpack8(*(const u32x4*)vp, v); unpack8(*(const u32x4*)(vp + 8), v + 8);
        float ssp = 0.f;
#pragma unroll
        for (int e = 0; e < 16; ++e) ssp += v[e] * v[e];
        ssp += __shfl_xor(ssp, 1); ssp += __shfl_xor(ssp, 2);
        const float rs = rsqrtf(ssp * (1.f / 64.f) + EPS);
#pragma unroll
        for (int e = 0; e < 16; e += 2) { const unsigned w = cvt_pk(v[e] * rs * vnorm[h * 64 + part * 16 + e], v[e + 1] * rs * vnorm[h * 64 + part * 16 + e + 1]);
            VnT[(part * 16 + e) * 136 + s] = (bf16_t)(w & 0xffffu); VnT[(part * 16 + e + 1) * 136 + s] = (bf16_t)(w >> 16); }
        if (stage_w) {
            const f32x4* wp = (const f32x4*)(w_s + (size_t)h * 128 * 128);
            f32x4 wv[8];
#pragma unroll
            for (int k = 0; k < 8; ++k) wv[k] = wp[tid + 512 * k];
#pragma unroll
            for (int k = 0; k < 8; ++k) { const int i4 = (tid + 512 * k) * 4, t = i4 >> 7, s2 = i4 & 127;
                u32x2 w; w.x = cvt_pk(s2 <= t ? wv[k][0] : 0.f, s2 + 1 <= t ? wv[k][1] : 0.f); w.y = cvt_pk(s2 + 2 <= t ? wv[k][2] : 0.f, s2 + 3 <= t ? wv[k][3] : 0.f);
                *(LAS u32x2*)(Wb + t * 136 + s2) = w; }
        }
    }
    __syncthreads();
    {
        f32x4 acc[4];
#pragma unroll
        for (int nt = 0; nt < 4; ++nt) acc[nt] = (f32x4){0.f, 0.f, 0.f, 0.f};
#pragma unroll
        for (int ks = 0; ks < 4; ++ks) {
            if (32 * ks <= 16 * wave + 15) {
                const bf16x8 bv = *(const LAS bf16x8*)(Wb + (16 * wave + fr) * 136 + 32 * ks + 8 * fq);
#pragma unroll
                for (int nt = 0; nt < 4; ++nt) {
                    const bf16x8 av = *(const LAS bf16x8*)(VnT + (16 * nt + fr) * 136 + 32 * ks + 8 * fq);
                    acc[nt] = __builtin_amdgcn_mfma_f32_16x16x32_bf16(av, bv, acc[nt], 0, 0, 0);
                }
            }
        }
        const int t = 16 * wave + fr;
        const float bias = b_s[h * 128 + t];
#pragma unroll
        for (int nt = 0; nt < 4; ++nt) {
            const int e0 = 16 * nt + 4 * fq;
            const u32x2 uw = *(const u32x2*)(Z + (row0 + t) * 2560 + h * 64 + e0);
            const float o0 = bf_lo(uw.x) * (acc[nt][0] + bias), o1 = bf_hi(uw.x) * (acc[nt][1] + bias), o2 = bf_lo(uw.y) * (acc[nt][2] + bias), o3 = bf_hi(uw.y) * (acc[nt][3] + bias);
            u32x2 ow; ow.x = cvt_pk(o0, o1); ow.y = cvt_pk(o2, o3);
            *(u32x2*)(MIX + (row0 + t) * DM + h * 64 + e0) = ow;
        }
    }
    __syncthreads();
}

__device__ __forceinline__ bf16_t f2bf(float x) { return (bf16_t)(cvt_pk(x, 0.f) & 0xffffu); }
#define HBAR() asm volatile("s_waitcnt lgkmcnt(0)\n\ts_barrier" ::: "memory")
__device__ __forceinline__ void hgrn_unit(LAS unsigned char* lds, int unit, const bf16_t* Z, const float* LF, bf16_t* OH, int tid, int lane, int wave) {
    asm volatile("" : "+v"(tid));
    lane = tid & 63;
    const int es = unit & 7, h = (unit >> 3) & 3, b = unit >> 5;
    LAS float* LFs = (LAS float*)lds;
    LAS bf16_t* Qs = (LAS bf16_t*)(lds + 32768);
    LAS bf16_t* Aq = (LAS bf16_t*)(lds + 49152);
    LAS bf16_t* Bk = (LAS bf16_t*)(lds + 66560);
    LAS bf16_t* Aqe = (LAS bf16_t*)(lds + 83968);
    LAS bf16_t* KKt = (LAS bf16_t*)(lds + 101376);
    LAS bf16_t* Vt = (LAS bf16_t*)(lds + 119808);
    LAS bf16_t* Pm = (LAS bf16_t*)(lds + 122112);
    LAS bf16_t* St = (LAS bf16_t*)(lds + 131328);
    LAS float* Gs = (LAS float*)(lds + 135680);
    LAS float* QS = (LAS float*)(lds + 136192);
    const int fr = lane & 15, fq = lane >> 4;
    for (int i = tid; i < 16 * 136 / 2; i += 512) ((LAS unsigned*)St)[i] = 0u;
    f32x4 st = (f32x4){0.f, 0.f, 0.f, 0.f};
    const int lt = tid >> 3, lpart = tid & 7;
    const int vt2 = tid >> 1, vpp = tid & 1;
    const int cd = tid & 127, ctq = tid >> 7;
    const size_t rowb = (size_t)b * SEQ;
    f32x4 plf[4]; u32x4 pq[2]; u32x4 pv = (u32x4){0u, 0u, 0u, 0u};
    {
        const float* lp = LF + (rowb + lt) * 512 + h * 128 + lpart * 16;
        const bf16_t* qp = Z + (rowb + lt) * 2560 + 1024 + h * 128 + lpart * 16;
#pragma unroll
        for (int j = 0; j < 4; ++j) plf[j] = *(const f32x4*)(lp + 4 * j);
        pq[0] = *(const u32x4*)qp; pq[1] = *(const u32x4*)(qp + 8);
        if (tid < 128) pv = *(const u32x4*)(Z + (rowb + vt2) * 2560 + 1536 + h * 128 + es * 16 + vpp * 8);
    }
#pragma unroll 1
    for (int c = 0; c < SEQ / 64; ++c) {
        const size_t row0 = rowb + (size_t)c * 64;
#pragma unroll
        for (int j = 0; j < 4; ++j) *(LAS f32x4*)(LFs + lt * 128 + lpart * 16 + 4 * j) = plf[j];
        *(LAS u32x4*)(Qs + lt * 128 + lpart * 16) = pq[0]; *(LAS u32x4*)(Qs + lt * 128 + lpart * 16 + 8) = pq[1];
        if (tid < 128) { const unsigned ww[4] = {pv.x, pv.y, pv.z, pv.w};
#pragma unroll
            for (int j = 0; j < 4; ++j) { Vt[(vpp * 8 + 2 * j) * 72 + vt2] = (bf16_t)(ww[j] & 0xffffu); Vt[(vpp * 8 + 2 * j + 1) * 72 + vt2] = (bf16_t)(ww[j] >> 16); } }
        HBAR();
        if (c + 1 < SEQ / 64) {
            const float* lp = LF + (row0 + 64 + lt) * 512 + h * 128 + lpart * 16;
            const bf16_t* qp = Z + (row0 + 64 + lt) * 2560 + 1024 + h * 128 + lpart * 16;
#pragma unroll
            for (int j = 0; j < 4; ++j) plf[j] = *(const f32x4*)(lp + 4 * j);
            pq[0] = *(const u32x4*)qp; pq[1] = *(const u32x4*)(qp + 8);
            if (tid < 128) pv = *(const u32x4*)(Z + (row0 + 64 + vt2) * 2560 + 1536 + h * 128 + es * 16 + vpp * 8);
        }
        float L[16]; float run = 0.f;
#pragma unroll
        for (int i = 0; i < 16; ++i) { run += LFs[(16 * ctq + i) * 128 + cd]; L[i] = run; }
        QS[ctq * 128 + cd] = run;
        HBAR();
        {
            const float q0 = QS[cd], q1 = QS[128 + cd], q2 = QS[256 + cd], q3 = QS[384 + cd];
            const float bref = q0 + q1, tot = (q0 + q1) + (q2 + q3);
            const float off = ctq == 0 ? 0.f : ctq == 1 ? q0 : ctq == 2 ? q0 + q1 : (q0 + q1) + q2;
            unsigned kkp[8];
            float lfv[16], qvv[16];
#pragma unroll
            for (int i = 0; i < 16; ++i) { const int t = 16 * ctq + i; lfv[i] = LFs[t * 128 + cd]; qvv[i] = bf_lo((unsigned)Qs[t * 128 + cd]); }
            const float ebref = __expf(bref), etb = __expf(tot - bref);
#pragma unroll
            for (int i = 0; i < 16; ++i) {
                const int t = 16 * ctq + i;
                const float B = L[i] + off;
                const float E = __expf(B - bref), Ei = fast_rcp(E);
                const float kv = 1.f - __expf(lfv[i]);
                Aq[t * 136 + cd] = f2bf(qvv[i] * E);
                Bk[t * 136 + cd] = f2bf(kv * Ei);
                Aqe[t * 136 + cd] = f2bf(qvv[i] * E * ebref);
                L[i] = kv * Ei * etb;
            }
#pragma unroll
            for (int i = 0; i < 8; ++i) kkp[i] = cvt_pk(L[2 * i], L[2 * i + 1]);
            *(LAS u32x4*)(KKt + cd * 72 + 16 * ctq) = (u32x4){kkp[0], kkp[1], kkp[2], kkp[3]};
            *(LAS u32x4*)(KKt + cd * 72 + 16 * ctq + 8) = (u32x4){kkp[4], kkp[5], kkp[6], kkp[7]};
            if (ctq == 0) Gs[cd] = __expf(tot);
        }
        HBAR();
        {
            const int tb = wave & 3, sbp = wave >> 2;
#pragma unroll
            for (int k2 = 0; k2 < 2; ++k2) {
                const int sb = 2 * sbp + k2;
                f32x4 acc = (f32x4){0.f, 0.f, 0.f, 0.f};
                if (sb <= tb) {
#pragma unroll
                    for (int ks = 0; ks < 4; ++ks) {
                        const bf16x8 av = *(const LAS bf16x8*)(Aq + (16 * tb + fr) * 136 + 32 * ks + 8 * fq);
                        const bf16x8 bv = *(const LAS bf16x8*)(Bk + (16 * sb + fr) * 136 + 32 * ks + 8 * fq);
                        acc = __builtin_amdgcn_mfma_f32_16x16x32_bf16(av, bv, acc, 0, 0, 0);
                    }
                    if (sb == tb) {
#pragma unroll
                        for (int i = 0; i < 4; ++i) if (fr > 4 * fq + i) acc[i] = 0.f;
                    }
                }
#pragma unroll
                for (int i = 0; i < 4; ++i) Pm[(16 * tb + 4 * fq + i) * 72 + 16 * sb + fr] = f2bf(acc[i]);
            }
        }
        HBAR();
        if (wave < 4) {
            const int tb = wave;
            f32x4 acc = (f32x4){0.f, 0.f, 0.f, 0.f};
#pragma unroll
            for (int ks = 0; ks < 2; ++ks) {
                const bf16x8 av = *(const LAS bf16x8*)(Pm + (16 * tb + fr) * 72 + 32 * ks + 8 * fq);
                const bf16x8 bv = *(const LAS bf16x8*)(Vt + fr * 72 + 32 * ks + 8 * fq);
                acc = __builtin_amdgcn_mfma_f32_16x16x32_bf16(av, bv, acc, 0, 0, 0);
            }
#pragma unroll
            for (int ks = 0; ks < 4; ++ks) {
                const bf16x8 av = *(const LAS bf16x8*)(Aqe + (16 * tb + fr) * 136 + 32 * ks + 8 * fq);
                const bf16x8 bv = *(const LAS bf16x8*)(St + fr * 136 + 32 * ks + 8 * fq);
                acc = __builtin_amdgcn_mfma_f32_16x16x32_bf16(av, bv, acc, 0, 0, 0);
            }
#pragma unroll
            for (int i = 0; i < 4; ++i) OH[(row0 + 16 * tb + 4 * fq + i) * 512 + h * 128 + es * 16 + fr] = f2bf(acc[i]);
        }
        {
            const f32x4 g = *(const LAS f32x4*)(Gs + 16 * wave + 4 * fq);
            st = st * g;
#pragma unroll
            for (int ks = 0; ks < 2; ++ks) {
                const bf16x8 av = *(const LAS bf16x8*)(KKt + (16 * wave + fr) * 72 + 32 * ks + 8 * fq);
                const bf16x8 bv = *(const LAS bf16x8*)(Vt + fr * 72 + 32 * ks + 8 * fq);
                st = __builtin_amdgcn_mfma_f32_16x16x32_bf16(av, bv, st, 0, 0, 0);
            }
        }
        HBAR();
        { u32x2 w; w.x = cvt_pk(st[0], st[1]); w.y = cvt_pk(st[2], st[3]); *(LAS u32x2*)(St + fr * 136 + 16 * wave + 4 * fq) = w; }
    }
    HBAR();
}
#undef HBAR
__device__ __forceinline__ void hgrn_onorm(const bf16_t* OH, const bf16_t* Z, const float* gain, bf16_t* MIX, int lane, int wave, int G) {
    const int gw = blockIdx.x * 8 + wave, NGW = G * 8;
    const int e0 = (8 * lane) & 127;
    const f32x4 g0 = *(const f32x4*)(gain + e0), g1 = *(const f32x4*)(gain + e0 + 4);
    for (int row = gw; row < M; row += 2 * NGW) {
        u32x4 ov[2], zv[2];
#pragma unroll
        for (int r = 0; r < 2; ++r) { const size_t rr = (size_t)(row + r * NGW); ov[r] = *(const u32x4*)(OH + rr * 512 + 8 * lane); zv[r] = *(const u32x4*)(Z + rr * 2560 + 2048 + 8 * lane); }
#pragma unroll
        for (int r = 0; r < 2; ++r) { const size_t rr = (size_t)(row + r * NGW);
            float v[8]; unpack8(ov[r], v);
            float ssp = 0.f;
#pragma unroll
            for (int e = 0; e < 8; ++e) ssp += v[e] * v[e];
            ssp += __shfl_xor(ssp, 1); ssp += __shfl_xor(ssp, 2); ssp += __shfl_xor(ssp, 4); ssp += __shfl_xor(ssp, 8);
            const float rs = rsqrtf(ssp * (1.f / 128.f) + EPS);
            float sg[8]; unpack8(zv[r], sg);
            float o[8];
#pragma unroll
            for (int e = 0; e < 4; ++e) { o[e] = v[e] * rs * g0[e] * sg[e]; o[4 + e] = v[4 + e] * rs * g1[e] * sg[4 + e]; }
            *(u32x4*)(MIX + rr * DM + 512 + 8 * lane) = pack8(o); }
    }
}

constexpr float QSCALE = 0.07216878364870323f * 1.4426950408889634f;
__device__ __forceinline__ void mla_prep_unit(LAS unsigned char* lds, int tb, bf16_t* Q, bf16_t* KV, const bf16_t* ZC, bf16_t* VT, const int* positions, const float* qnorm, const float* knorm, int tid, int lane, int wave) {
    asm volatile("" : "+v"(tid));
    lane = tid & 63;
    const size_t r0 = (size_t)tb * 64; const int b = (int)(r0 / SEQ), s0 = (int)(r0 % SEQ);
    LAS float* RS = (LAS float*)lds;
    {
        const int tok = tid >> 3, part = tid & 7;
        const bf16_t* cp = ZC + (r0 + tok) * 768 + 384 + part * 32;
        float ssp = 0.f;
#pragma unroll
        for (int c = 0; c < 4; ++c) { float v[8]; unpack8(*(const u32x4*)(cp + 8 * c), v);
#pragma unroll
            for (int j = 0; j < 8; ++j) ssp += v[j] * v[j]; }
        ssp += __shfl_xor(ssp, 1); ssp += __shfl_xor(ssp, 2); ssp += __shfl_xor(ssp, 4);
        if (part == 0) RS[tok] = rsqrtf(ssp * (1.f / 256.f) + EPS);
    }
    __syncthreads();
#pragma unroll 4
    for (int k = 0; k < 16; ++k) {
        const int ci = tid + 512 * k, tok = ci >> 7, c8 = (ci & 127) * 8;
        bf16_t* vp = VT + (r0 + tok) * 1024 + c8;
        float v[8]; unpack8(*(const u32x4*)vp, v);
        const float rk = RS[tok];
#pragma unroll
        for (int j = 0; j < 8; ++j) v[j] *= rk;
        *(u32x4*)vp = pack8(v);
    }
    const int half = lane >> 5, rl = lane & 31; const bool act = rl < 24;
    const float invf = exp2f(-(float)rl * 0.4152410118609203f);
    float qg[8], kg[8];
#pragma unroll
    for (int j = 0; j < 8; ++j) { qg[j] = act ? qnorm[8 * rl + j] : 0.f; kg[j] = act ? knorm[8 * rl + j] : 0.f; }
    const bool ropeA = (rl >= 16 && rl < 20), ropeB = (rl >= 20 && rl < 24);
    const int rla = act ? rl : 0;
    u32x4 qc[4], kc[4], qn[4], kn[4]; int pc, pn;
    {
        const size_t row = r0 + wave * 8;
        pc = positions[row];
#pragma unroll
        for (int hp = 0; hp < 4; ++hp) { const int head = 2 * hp + half;
            qc[hp] = *(const u32x4*)(Q + row * 1536 + head * 192 + 8 * rla);
            kc[hp] = (rl >= 16 && act) ? *(const u32x4*)(ZC + row * 768 + 640 + 8 * (rl - 16)) : *(const u32x4*)(KV + row * 1536 + head * 192 + 8 * rla); }
    }
    pn = pc;
#pragma unroll
    for (int hp = 0; hp < 4; ++hp) { qn[hp] = qc[hp]; kn[hp] = kc[hp]; }
#pragma unroll 1
    for (int rr = 0; rr < 8; ++rr) {
        const size_t row = r0 + wave * 8 + rr;
        if (rr + 1 < 8) {
            const size_t rown = row + 1;
            pn = positions[rown];
#pragma unroll
            for (int hp = 0; hp < 4; ++hp) { const int head = 2 * hp + half;
                qn[hp] = *(const u32x4*)(Q + rown * 1536 + head * 192 + 8 * rla);
                kn[hp] = (rl >= 16 && act) ? *(const u32x4*)(ZC + rown * 768 + 640 + 8 * (rl - 16)) : *(const u32x4*)(KV + rown * 1536 + head * 192 + 8 * rla); }
        }
        const float ang = (float)pc * invf;
        float sn, cs; sincosf(ang, &sn, &cs);
        float cv[8], sv[8];
#pragma unroll
        for (int j = 0; j < 8; ++j) { const int src = (lane & 32) + 8 * (rl & 3) + j; cv[j] = __shfl(cs, src); sv[j] = __shfl(sn, src); }
        const float rk = RS[wave * 8 + rr];
#pragma unroll
        for (int hp = 0; hp < 4; ++hp) { const int head = 2 * hp + half;
            bf16_t* qp = Q + row * 1536 + head * 192 + 8 * rl;
            float v[8]; unpack8(qc[hp], v);
            if (!act) {
#pragma unroll
                for (int j = 0; j < 8; ++j) v[j] = 0.f; }
            float ssp = 0.f;
#pragma unroll
            for (int j = 0; j < 8; ++j) ssp += v[j] * v[j];
            ssp += __shfl_xor(ssp, 1); ssp += __shfl_xor(ssp, 2); ssp += __shfl_xor(ssp, 4); ssp += __shfl_xor(ssp, 8); ssp += __shfl_xor(ssp, 16);
            const float rs = rsqrtf(ssp * (1.f / 192.f) + EPS);
#pragma unroll
            for (int j = 0; j < 8; ++j) v[j] = v[j] * rs * qg[j];
#pragma unroll
            for (int j = 0; j < 8; ++j) { const float pr = __shfl_xor(v[j], 4); if (ropeA) v[j] = v[j] * cv[j] - pr * sv[j]; else if (ropeB) v[j] = v[j] * cv[j] + pr * sv[j]; }
#pragma unroll
            for (int j = 0; j < 8; ++j) v[j] *= QSCALE;
            if (act) *(u32x4*)qp = pack8(v);
        }
#pragma unroll
        for (int hp = 0; hp < 4; ++hp) { const int head = 2 * hp + half;
            bf16_t* kp = KV + row * 1536 + head * 192 + 8 * rl;
            float v[8]; unpack8(kc[hp], v);
            if (rl < 16) {
#pragma unroll
                for (int j = 0; j < 8; ++j) v[j] *= rk; }
            else if (!act) {
#pragma unroll
                for (int j = 0; j < 8; ++j) v[j] = 0.f; }
            float ssp = 0.f;
#pragma unroll
            for (int j = 0; j < 8; ++j) ssp += v[j] * v[j];
            ssp += __shfl_xor(ssp, 1); ssp += __shfl_xor(ssp, 2); ssp += __shfl_xor(ssp, 4); ssp += __shfl_xor(ssp, 8); ssp += __shfl_xor(ssp, 16);
            const float rs = rsqrtf(ssp * (1.f / 192.f) + EPS);
#pragma unroll
            for (int j = 0; j < 8; ++j) v[j] = v[j] * rs * kg[j];
#pragma unroll
            for (int j = 0; j < 8; ++j) { const float pr = __shfl_xor(v[j], 4); if (ropeA) v[j] = v[j] * cv[j] - pr * sv[j]; else if (ropeB) v[j] = v[j] * cv[j] + pr * sv[j]; }
            if (act) *(u32x4*)kp = pack8(v);
        }
        pc = pn;
#pragma unroll
        for (int hp = 0; hp < 4; ++hp) { qc[hp] = qn[hp]; kc[hp] = kn[hp]; }
    }
    __syncthreads();
}

__device__ __forceinline__ int crow(int r, int hi) { return (r & 3) + 8 * (r >> 2) + 4 * hi; }
__device__ __forceinline__ void attn_unit(LAS unsigned char* lds, int bh, int qb, const bf16_t* QN, const bf16_t* KV, const bf16_t* VT, bf16_t* AO, int lane, int wid) {
    asm volatile("" : "+v"(lane));
    const int r32 = lane & 31, hi = lane >> 5;
    const int b = bh >> 3, h = bh & 7;
    const size_t rowbase = (size_t)b * SEQ;
    const int qw0 = qb * 256 + wid * 32;
    bf16x8 qf[12];
    {
        const bf16_t* qp = QN + (rowbase + qw0 + r32) * 1536 + h * 192 + 8 * hi;
#pragma unroll
        for (int ks = 0; ks < 12; ++ks) qf[ks] = *(const bf16x8*)(qp + 16 * ks);
    }
    const float zf = opaque_zero();
    f32x16 o[4];
#pragma unroll
    for (int d = 0; d < 4; ++d)
#pragma unroll
        for (int r = 0; r < 16; ++r) o[d][r] = zf;
    float m_run = -1e30f, l_run = 0.f;
    const int NT = 4 * qb + 4;
    const bf16_t* ksrc = KV + rowbase * 1536 + h * 192;
    int koff[3];
#pragma unroll
    for (int i_ = 0; i_ < 3; ++i_) { const int idx = 64 * (wid + 8 * i_) + lane, r = idx / 24, cs = idx - 24 * r, c = (cs & ~7) | ((cs ^ (r >> 1)) & 7); koff[i_] = r * 1536 + 8 * c; }
    int okj[4];
#pragma unroll
    for (int j_ = 0; j_ < 4; ++j_) okj[j_] = r32 * 384 + ((((2 * j_ + hi) ^ (r32 >> 1)) & 7) * 16);
    const bf16_t* vsrc = VT + (rowbase + (lane >> 4)) * 1024 + h * 128 + 8 * ((lane & 15) ^ ((lane >> 4) << 2));
#define ATT_ISSUE(t_, st_) do { LAS unsigned char* Ks_ = lds + (st_) * 40960; LAS unsigned char* Vs_ = Ks_ + 24576; \
        _Pragma("unroll") for (int i_ = 0; i_ < 3; ++i_) { const int c_ = wid + 8 * i_; \
            __builtin_amdgcn_global_load_lds((const unsigned*)(ksrc + (size_t)(t_) * 64 * 1536 + koff[i_]), (LAS unsigned*)(Ks_ + c_ * 1024), 16, 0, 0); } \
        _Pragma("unroll") for (int i_ = 0; i_ < 2; ++i_) { const int p_ = wid + 8 * i_; \
            __builtin_amdgcn_global_load_lds((const unsigned*)(vsrc + (size_t)((t_) * 64 + 4 * p_) * 1024), (LAS unsigned*)(Vs_ + p_ * 1024), 16, 0, 0); } } while (0)
    const int tq = (lane & 15) >> 2, tp = lane & 3, tdg = (lane >> 4) & 1;
    ATT_ISSUE(0, 0);
    for (int t = 0; t < NT; ++t) {
        asm volatile("s_waitcnt vmcnt(0) lgkmcnt(0)\n\ts_barrier" ::: "memory");
        if (t + 1 < NT) ATT_ISSUE(t + 1, (t + 1) & 1);
        const int kv0 = 64 * t;
        if (kv0 <= qw0 + 31) {
            const LAS unsigned char* Ks = lds + (t & 1) * 40960; const LAS unsigned char* Vs = Ks + 24576;
            f32x16 p0, p1;
#pragma unroll
            for (int r = 0; r < 16; ++r) { p0[r] = zf; p1[r] = zf; }
#pragma unroll
            for (int ks = 0; ks < 12; ++ks) {
                const LAS unsigned char* kp = Ks + okj[ks & 3] + (ks >> 2) * 128;
                const bf16x8 k0 = *(const LAS bf16x8*)kp, k1 = *(const LAS bf16x8*)(kp + 12288);
                p0 = __builtin_amdgcn_mfma_f32_32x32x16_bf16(k0, qf[ks], p0, 0, 0, 0);
                p1 = __builtin_amdgcn_mfma_f32_32x32x16_bf16(k1, qf[ks], p1, 0, 0, 0);
            }
            if (kv0 + 63 > qw0) {
                const int qi = qw0 + r32;
#pragma unroll
                for (int r = 0; r < 16; ++r) { const int kvi = kv0 + crow(r, hi); if (kvi > qi) p0[r] = -1e30f; if (kvi + 32 > qi) p1[r] = -1e30f; }
            }
            float mx = fmaxf(p0[0], p1[0]);
#pragma unroll
            for (int r = 1; r < 16; ++r) mx = fmaxf(mx, fmaxf(p0[r], p1[r]));
            mx = fmaxf(mx, __shfl_xor(mx, 32));
            const float mn = fmaxf(m_run, mx);
            const float alpha = __builtin_amdgcn_exp2f(m_run - mn);
            m_run = mn;
            float sum = 0.f;
#pragma unroll
            for (int r = 0; r < 16; ++r) { p0[r] = __builtin_amdgcn_exp2f(p0[r] - mn); p1[r] = __builtin_amdgcn_exp2f(p1[r] - mn); sum += p0[r] + p1[r]; }
            l_run = l_run * alpha + sum;
            if (__any(alpha != 1.f)) {
#pragma unroll
                for (int d = 0; d < 4; ++d)
#pragma unroll
                    for (int r = 0; r < 16; ++r) o[d][r] *= alpha;
            }
            bf16x8 pf[4];
            {
                u32x4 w;
                w.x = cvt_pk(p0[0], p0[1]); w.y = cvt_pk(p0[2], p0[3]); w.z = cvt_pk(p0[4], p0[5]); w.w = cvt_pk(p0[6], p0[7]); pf[0] = __builtin_bit_cast(bf16x8, w);
                w.x = cvt_pk(p0[8], p0[9]); w.y = cvt_pk(p0[10], p0[11]); w.z = cvt_pk(p0[12], p0[13]); w.w = cvt_pk(p0[14], p0[15]); pf[1] = __builtin_bit_cast(bf16x8, w);
                w.x = cvt_pk(p1[0], p1[1]); w.y = cvt_pk(p1[2], p1[3]); w.z = cvt_pk(p1[4], p1[5]); w.w = cvt_pk(p1[6], p1[7]); pf[2] = __builtin_bit_cast(bf16x8, w);
                w.x = cvt_pk(p1[8], p1[9]); w.y = cvt_pk(p1[10], p1[11]); w.z = cvt_pk(p1[12], p1[13]); w.w = cvt_pk(p1[14], p1[15]); pf[3] = __builtin_bit_cast(bf16x8, w);
            }
#pragma unroll
            for (int d = 0; d < 4; ++d)
#pragma unroll
                for (int i = 0; i < 4; ++i) {
                    const LAS unsigned char* va = Vs + (16 * i + 4 * hi + tq) * 256 + (4 * (d ^ tq) + 2 * tdg + (tp >> 1)) * 16 + (tp & 1) * 8;
                    const s16x4 lo4 = __builtin_bit_cast(s16x4, __builtin_amdgcn_ds_read_tr16_b64_v4i16((LAS v4i16_t*)va));
                    const s16x4 hi4 = __builtin_bit_cast(s16x4, __builtin_amdgcn_ds_read_tr16_b64_v4i16((LAS v4i16_t*)(va + 8 * 256)));
                    const bf16x8 vf = (bf16x8){lo4[0], lo4[1], lo4[2], lo4[3], hi4[0], hi4[1], hi4[2], hi4[3]};
                    o[d] = __builtin_amdgcn_mfma_f32_32x32x16_bf16(vf, pf[i], o[d], 0, 0, 0);
                }
        }
    }
#undef ATT_ISSUE
    const float lt = l_run + __shfl_xor(l_run, 32);
    const float inv = 1.f / lt;
    bf16_t* op = AO + (rowbase + qw0 + r32) * DM + h * 128;
#pragma unroll
    for (int d = 0; d < 4; ++d)
#pragma unroll
        for (int g4 = 0; g4 < 4; ++g4) {
            u32x2 w; w.x = cvt_pk(o[d][4 * g4] * inv, o[d][4 * g4 + 1] * inv); w.y = cvt_pk(o[d][4 * g4 + 2] * inv, o[d][4 * g4 + 3] * inv);
            *(u32x2*)(op + 32 * d + 8 * g4 + 4 * hi) = w;
        }
}

#define XB_TMO      128
#define XB_XCNT(j)  (256  + 64 * (j))
#define XB_XSUB(j)  (1280 + 64 * (j))
#define XB_XGEN(j)  (2304 + 64 * (j))
#define XB_TOP      3328
#define XB_TOPGEN   3392
#define XCD_BAR_WORDS 3456
#define XB_SPIN_CAP (1u << 20)
__device__ __forceinline__ unsigned xb_ld(unsigned* p)              { return __hip_atomic_load(p, __ATOMIC_RELAXED, __HIP_MEMORY_SCOPE_AGENT); }
__device__ __forceinline__ unsigned xb_add(unsigned* p, unsigned v) { return __hip_atomic_fetch_add(p, v, __ATOMIC_RELAXED, __HIP_MEMORY_SCOPE_AGENT); }
__device__ __forceinline__ unsigned xb_xcc_id() { return (unsigned)__builtin_amdgcn_s_getreg((3 << 11) | 20) & 0xFu; }
#define XB_SPIN(cond, bar) do { unsigned _sp = 0; while (cond) { __builtin_amdgcn_s_sleep(1); \
    if ((++_sp & 255u) == 0u) { if (xb_ld(&(bar)[XB_TMO])) break; if (_sp > XB_SPIN_CAP) { atomicAdd(&(bar)[XB_TMO], 1u); break; } } } } while (0)
struct XcdBarrier { unsigned* bar; unsigned x; volatile LAS unsigned* st; };
__device__ __forceinline__ void xcd_barrier_complete(unsigned* bar, unsigned x, unsigned& nloc, unsigned& nx) {
    const unsigned G = gridDim.x * gridDim.y * gridDim.z;
    unsigned sum, cnt, mine, sp = 0u;
    for (;;) {
        sum = 0u; cnt = 0u; mine = 0u;
#pragma unroll
        for (unsigned j = 0; j < 16; ++j) { const unsigned c = xb_ld(&bar[XB_XCNT(j)]); sum += c; cnt += (c > 0u) ? 1u : 0u; mine = (j == x) ? c : mine; }
        if (sum == G) break;
        __builtin_amdgcn_s_sleep(1);
        if ((++sp & 255u) == 0u) { if (xb_ld(&bar[XB_TMO])) break; if (sp > XB_SPIN_CAP) { atomicAdd(&bar[XB_TMO], 1u); break; } }
    }
    nloc = mine > 0u ? mine : 1u; nx = cnt > 0u ? cnt : 1u;
}
__device__ __forceinline__ void xcd_barrier(const XcdBarrier& b) {
    asm volatile("s_waitcnt vmcnt(0)" ::: "memory");
    __syncthreads();
    if (threadIdx.x == 0) {
        unsigned* bar = b.bar;
        __builtin_amdgcn_s_waitcnt(0);
        unsigned nloc = b.st[0], nx = b.st[1];
        if (nloc == 0u) { xcd_barrier_complete(bar, b.x, nloc, nx); b.st[0] = nloc; b.st[1] = nx; }
        const unsigned old = xb_add(&bar[XB_XSUB(b.x)], 1u);
        const unsigned gen = old / nloc;
        if (old + 1u == (gen + 1u) * nloc) {
            __builtin_amdgcn_fence(__ATOMIC_RELEASE, "agent");
            asm volatile("s_waitcnt vmcnt(0)" ::: "memory");
            const unsigned og = xb_add(&bar[XB_TOP], 1u);
            const unsigned tg = og / nx;
            if (og + 1u == (tg + 1u) * nx) xb_add(&bar[XB_TOPGEN], 1u);
            else XB_SPIN(xb_ld(&bar[XB_TOPGEN]) == tg, bar);
            __builtin_amdgcn_fence(__ATOMIC_ACQUIRE, "agent");
            xb_add(&bar[XB_XGEN(b.x)], 1u);
            asm volatile("s_waitcnt vmcnt(0)" ::: "memory");
        } else {
            XB_SPIN(xb_ld(&bar[XB_XGEN(b.x)]) == gen, bar);
            __builtin_amdgcn_fence(__ATOMIC_ACQUIRE, "agent");
            asm volatile("s_waitcnt vmcnt(0)" ::: "memory");
        }
    }
    __syncthreads();
}

__global__ void __launch_bounds__(512, 2) mk_fwd(Args a) {
    extern __shared__ __attribute__((aligned(16))) unsigned char lds_raw[];
    cg::grid_group grid = cg::this_grid();
    const int tid0 = threadIdx.x;
    volatile LAS unsigned* xst = (volatile LAS unsigned*)((LAS unsigned char*)lds_raw + (LDS_BYTES - 64));
    if (tid0 < 16) xst[tid0] = 0u;
    __syncthreads();
    XcdBarrier xbar; xbar.bar = (unsigned*)a.ws; xbar.x = xb_xcc_id(); xbar.st = xst;
    if (MK_SINGLE && tid0 == 0) (void)xb_add(&xbar.bar[XB_XCNT(xbar.x)], 1u);
    for (int ph = a.ph_lo; ph < a.ph_hi; ++ph) {
        int tid = tid0; asm volatile("" : "+v"(tid));
        size_t zo = 0; asm volatile("" : "+s"(zo));
        int G = gridDim.x; asm volatile("" : "+s"(G));
        int bx = blockIdx.x; asm volatile("" : "+s"(bx));
        LAS unsigned char* lds = (LAS unsigned char*)lds_raw + zo;
        const int lane = tid & 63, wave = rfl(tid >> 6);
        const int vcu = (G % 8 == 0) ? (bx % 8) * (G / 8) + bx / 8 : bx;
        unsigned char* ws = a.ws + zo;
        ss_t* SS = (ss_t*)(ws + WS_SS);
        float* X = a.out + zo;
        bf16_t* XB = (bf16_t*)(ws + WS_XB);
        const float* ng = (const float*)a.in[3] + zo;
#define AIN(k) ((const float*)a.in[k] + zo)
        if (ph == 0) {
            if (EN & 512) p0_prologue(a, lds, tid, lane, wave, G, bx, zo);
        } else {
            const int i = (ph - 1) / NSUB, s = (ph - 1) % NSUB, j = i >> 1; const bool even = (i & 1) == 0;
            unsigned char* wl = ws + WS_W + (size_t)i * LW_STRIDE;
            unsigned char* we = ws + WS_WE + (size_t)j * WE_STRIDE;
            unsigned char* wo = ws + WS_WO + (size_t)j * WO_STRIDE;
            ss_t* ssb = SS + (size_t)i * 7 * M;
            if (s == 3 && even) {
                const bf16_t* Z = (const bf16_t*)(ws + WS_Z);
                if (EN & 1) for (int rep = 0; rep < 1 + PROBE_HGRN; ++rep) for (int u_ = bx; u_ < 256; u_ += G) hgrn_unit(lds, (G == 256) ? (((u_ & 7) * 4 + (u_ >> 6)) * 8 + ((u_ >> 3) & 7)) : u_, Z,     (const float*)(ws + WS_LF), (bf16_t*)(ws + WS_OH), tid, lane, wave);
                if (EN & 2) for (int u = bx; u < 2048; u += G) gmlp_unit(lds, u, Z, AIN(11) + (size_t)j * 8 * 128 * 128, AIN(12) + j * 8 * 128, AIN(10) + j * 512, (bf16_t*)(ws + WS_MIX), tid, (G & 7) != 0 || u == bx);
            } else if (s == 4 && even) {
                hgrn_onorm((const bf16_t*)(ws + WS_OH), (const bf16_t*)(ws + WS_Z), AIN(14) + j * 128, (bf16_t*)(ws + WS_MIX), lane, wave, G);
            } else if (s == 4 && !even) {
                if (EN & 4) for (int u = bx; u < 512; u += G) mla_prep_unit(lds, u, (bf16_t*)(ws + WS_Q), (bf16_t*)(ws + WS_KV), (const bf16_t*)(ws + WS_ZC), (bf16_t*)(ws + WS_VT), (const int*)AIN(2), AIN(21) + j * 192, AIN(22) + j * 192, tid, lane, wave);
            } else if (s == 5 && !even && !(EN & 8)) {
                const bf16_t* Qp = (const bf16_t*)(ws + WS_Q); const bf16_t* Kp = (const bf16_t*)(ws + WS_KV); bf16_t* Ap = (bf16_t*)(ws + WS_AO);
                for (size_t idx = (size_t)bx * 512 + tid; idx < (size_t)M * 128; idx += (size_t)G * 512) {
                    const size_t row = idx >> 7, c8 = (idx & 127) * 8;
                    float qv[8], kv[8], q2[8], k2[8], vt[8]; unpack8(*(const u32x4*)(Qp + row * 1536 + c8), qv); unpack8(*(const u32x4*)(Kp + row * 1536 + c8), kv);
                    unpack8(*(const u32x4*)(Qp + row * 1536 + 512 + c8), q2); unpack8(*(const u32x4*)(Kp + row * 1536 + 512 + c8), k2);
                    unpack8(*(const u32x4*)((const bf16_t*)(ws + WS_VT) + row * 1024 + c8), vt);
#pragma unroll
                    for (int e = 0; e < 8; ++e) qv[e] = 0.5f * (STQ * (qv[e] + q2[e]) + STK * (kv[e] + k2[e]) + STV * vt[e]);
                    *(u32x4*)(Ap + row * 1024 + c8) = pack8(qv);
                }
            } else if (s == 5 && !even) {
                if (EN & 8) for (int rep = 0; rep < 1 + PROBE_ATT; ++rep) for (int v = vcu; v < 256; v += G) {
                    const int bh = v >> 2, sx = v & 3;
#pragma unroll 1
                    for (int k = 0; k < 4; ++k) { const int qb = (k == 0) ? 15 - sx : (k == 1) ? 8 + sx : (k == 2) ? 7 - sx : sx;
                        attn_unit(lds, bh, qb, (const bf16_t*)(ws + WS_Q), (const bf16_t*)(ws + WS_KV), (const bf16_t*)(ws + WS_VT), (bf16_t*)(ws + WS_AO), lane, wave); }
                }
                __syncthreads();
            } else if (s == 7) {
                p_convert(AIN(1) + (size_t)i * M * 256, (bf16_t*)(ws + WS_PB), tid, G);
            } else if (s == 10) {
                ple_finalize(i == DEPTH - 1 ? X : (float*)nullptr, (const bf16_t*)(ws + WS_TBUF), ssb + 4 * M, ng + (i * 5 + 4) * 1024, XB, SS + (size_t)(i + 1) * 7 * M, lane, wave, G);
            }
            __syncthreads();
            if (s == 0 || s == 7) {
                pg8::EpiUp E{(bf16_t*)(ws + WS_ACT), ssb + (s ? 2 : 0) * M};
                if (EN & 16) pg8::gemm_phase<2 * DFF, DM, DM, DM>(lds, XB, (const bf16_t*)(wl + (s ? OFF_WUP1 : OFF_WUP0)), G, tid, E);
            } else if (s == 1 || s == 8) {
                pg8::EpiResid E{XB, ssb + (s == 8 ? 3 : 1) * M, 0.5f};
                if (EN & 32) pg8::gemm_phase<DM, DFF, DFF, DFF>(lds, (const bf16_t*)(ws + WS_ACT), (const bf16_t*)(wl + (s == 8 ? OFF_WDN1 : OFF_WDN0)), G, tid, E);
                if (s == 8) {
                    __syncthreads();
                    pg8::EpiScale E2{(bf16_t*)(ws + WS_PBUF), DM, nullptr, 0.f, nullptr, nullptr, 0};
                    if (EN & 64) pg8::gemm_phase<DM, 256, 256, 256>(lds, (const bf16_t*)(ws + WS_PB), (const bf16_t*)(wl + OFF_WPP), G, tid, E2);
                }
            } else if (s == 2 && even) {
                pg8::EpiEvenIn E{(bf16_t*)(ws + WS_Z), (float*)(ws + WS_LF), ssb + 1 * M, (const float*)(ws + WS_LB) + j * 512};
                if (EN & 128) pg8::gemm_phase<3072, DM, DM, DM>(lds, XB, (const bf16_t*)(we + OFF_WEIN), G, tid, E);
            } else if (s == 2) {
                pg8::EpiScale E{(bf16_t*)(ws + WS_ZC), 768, ssb + 1 * M, 1.f / 1024.f, nullptr, nullptr, 0};
                if (EN & 64) pg8::gemm_phase<768, DM, DM, DM>(lds, XB, (const bf16_t*)(wo + OFF_WMIN), G, tid, E);
            } else if (s == 3 && !even) {
                pg8::EpiScale E{(bf16_t*)(ws + WS_Q), 1536, nullptr, 0.f, nullptr, nullptr, 0};
                if (EN & 64) pg8::gemm_phase<1536, 384, 768, 384>(lds, (const bf16_t*)(ws + WS_ZC), (const bf16_t*)(wo + OFF_WQB), G, tid, E);
                __syncthreads();
                pg8::EpiKV E2{(bf16_t*)(ws + WS_KV), (bf16_t*)(ws + WS_VT), ssb + 6 * M};
                if (EN & 64) pg8::gemm_phase<2048, 256, 768, 256>(lds, (const bf16_t*)(ws + WS_ZC) + 384, (const bf16_t*)(wo + OFF_WKVB), G, tid, E2);
            } else if (s == 6) {
                pg8::EpiResid E{XB, ssb + 2 * M, 1.0f};
                if (EN & 32) pg8::gemm_phase<DM, DM, DM, DM>(lds, (const bf16_t*)(ws + (even ? WS_MIX : WS_AO)), (const bf16_t*)(even ? we + OFF_WEOUT : wo + OFF_WMOUT), G, tid, E);
            } else if (s == 9) {
                pg8::EpiPleG E{(const bf16_t*)(ws + WS_PBUF), (bf16_t*)(ws + WS_TBUF), ssb + 3 * M, ssb + 4 * M};
                if (EN & 256) pg8::gemm_phase<DM, DM, DM, DM>(lds, XB, (const bf16_t*)(wl + OFF_WPG), G, tid, E);
            }
        }
        if (ph + 1 < a.ph_hi) {
            if (ph >= 1 && ((ph - 1) % NSUB) == 5 && ((((ph - 1) / NSUB) & 1) == 0)) continue;
            if (ph == 0) grid.sync(); else xcd_barrier(xbar);
            if (PROBE_SYNC) xcd_barrier(xbar);
        }
    }
}

extern "C" void kernel_launch(void* const* d_in, const int* in_sizes, int n_in, void* d_out, int out_size, void* d_ws, size_t ws_size, hipStream_t stream) {
    static int grid = 0;
    if (grid == 0) {
        if (n_in != 24 || out_size != M * DM || ws_size < WS_END) { fprintf(stderr, "kernel_launch: unexpected problem (n_in %d out %d ws %zu)\n", n_in, out_size, ws_size); grid = -1; return; }
        int dev = 0, cus = 0, per_cu = 0;
        hipGetDevice(&dev); hipDeviceGetAttribute(&cus, hipDeviceAttributeMultiprocessorCount, dev);
        hipFuncSetAttribute((const void*)mk_fwd, hipFuncAttributeMaxDynamicSharedMemorySize, LDS_BYTES);
        if (hipOccupancyMaxActiveBlocksPerMultiprocessor(&per_cu, (const void*)mk_fwd, 512, LDS_BYTES) != hipSuccess || per_cu < 1) { fprintf(stderr, "kernel_launch: occupancy query says %d\n", per_cu); per_cu = 1; }
        (void)hipGetLastError();
        grid = cus;
    }
    if (grid < 0) return;
    Args a{};
    for (int i = 0; i < 24; ++i) a.in[i] = d_in[i];
    a.out = (float*)d_out; a.ws = (unsigned char*)d_ws;
#if MK_SINGLE
    (void)hipMemsetAsync(d_ws, 0, 16384, stream);
    a.ph_lo = 0; a.ph_hi = NPH;
    void* args[] = {&a};
    hipError_t e = hipLaunchCooperativeKernel((const void*)mk_fwd, dim3(grid), dim3(512), args, LDS_BYTES, stream);
    if (e != hipSuccess) fprintf(stderr, "cooperative launch failed: %s (grid %d)\n", hipGetErrorString(e), grid);
#else
    for (int ph = 0; ph < NPH; ++ph) {
        a.ph_lo = ph; a.ph_hi = ph + 1;
        hipLaunchKernelGGL(mk_fwd, dim3(grid), dim3(512), LDS_BYTES, stream, a);
    }
#endif
}
```

```cpp
#include <hip/hip_runtime.h>
#include <hip/hip_cooperative_groups.h>
#include <cstdio>
#include <cstdint>
namespace cg = cooperative_groups;

#ifndef MK_SINGLE
#define MK_SINGLE 1
#endif
#ifndef EN
#define EN 0xffff
#ifndef PROBE_SYNC
#define PROBE_SYNC 0
#endif
#ifndef PROBE_HGRN
#define PROBE_HGRN 0
#endif
#ifndef PROBE_ATT
#define PROBE_ATT 0
#endif
#define VTEST 0
#define STQ 0.f
#define STK 0.f
#define STV 1.f
#endif

#define LAS __attribute__((address_space(3)))
typedef unsigned short bf16_t;
typedef short bf16x8 __attribute__((ext_vector_type(8)));
typedef float f32x4 __attribute__((ext_vector_type(4)));
typedef float f32x16 __attribute__((ext_vector_type(16)));
typedef unsigned u32x4 __attribute__((ext_vector_type(4)));
typedef unsigned u32x2 __attribute__((ext_vector_type(2)));
typedef short s16x4 __attribute__((ext_vector_type(4)));
typedef short v4i16_t __attribute__((ext_vector_type(4)));

constexpr int M = 32768, DM = 1024, SEQ = 4096, DFF = 2816, DEPTH = 4;
constexpr float EPS = 1e-6f;
constexpr int NSUB = 11, NPH = 1 + DEPTH * NSUB;

constexpr size_t MiB = 1u << 20;
constexpr size_t WS_SS = 576 * MiB;
constexpr size_t WS_LB = 3840 * 1024;
constexpr size_t WS_W = 4 * MiB;
constexpr size_t LW_STRIDE = 36 * MiB;
constexpr size_t OFF_WUP0 = 0, OFF_WUP1 = 11 * MiB, OFF_WDN0 = 22 * MiB, OFF_WDN1 = 22 * MiB + 5632 * 1024, OFF_WPG = 33 * MiB, OFF_WPP = 35 * MiB;
constexpr size_t WS_WE = 148 * MiB, WE_STRIDE = 8 * MiB, OFF_WEIN = 0, OFF_WEOUT = 6 * MiB;
constexpr size_t WS_WO = 164 * MiB, WO_STRIDE = 6 * MiB, OFF_WMIN = 0, OFF_WQB = 1536 * 1024, OFF_WKVB = 2816 * 1024, OFF_WMOUT = 3840 * 1024;
constexpr size_t WS_XB = 176 * MiB;
constexpr size_t WS_PB = 240 * MiB;
constexpr size_t WS_BIG = 256 * MiB;
constexpr size_t WS_ACT = WS_BIG;
constexpr size_t WS_PBUF = 432 * MiB;
constexpr size_t WS_TBUF = WS_BIG;
constexpr size_t WS_Z = WS_BIG;
constexpr size_t WS_LF = 416 * MiB;
constexpr size_t WS_MIX = 480 * MiB;
constexpr size_t WS_AO = WS_BIG;
constexpr size_t WS_ZC = WS_BIG;
constexpr size_t WS_Q = 320 * MiB;
constexpr size_t WS_KV = 416 * MiB;
constexpr size_t WS_OH = 544 * MiB;
constexpr size_t WS_VT = 512 * MiB;
constexpr size_t WS_END = 584 * MiB;

constexpr int LDS_BYTES = 147456;

typedef float f32x2_t __attribute__((ext_vector_type(2)));
typedef __bf16 bf16x2_t __attribute__((ext_vector_type(2)));
__device__ __forceinline__ unsigned cvt_pk(float lo, float hi) { f32x2_t v = {lo, hi}; bf16x2_t b = __builtin_convertvector(v, bf16x2_t); return __builtin_bit_cast(unsigned, b); }
__device__ __forceinline__ float bf_lo(unsigned w) { return __uint_as_float(w << 16); }
__device__ __forceinline__ float bf_hi(unsigned w) { return __uint_as_float(w & 0xffff0000u); }
__device__ __forceinline__ void unpack8(const u32x4 w, float* f) { f[0] = bf_lo(w.x); f[1] = bf_hi(w.x); f[2] = bf_lo(w.y); f[3] = bf_hi(w.y); f[4] = bf_lo(w.z); f[5] = bf_hi(w.z); f[6] = bf_lo(w.w); f[7] = bf_hi(w.w); }
__device__ __forceinline__ u32x4 pack8(const float* f) { u32x4 w; w.x = cvt_pk(f[0], f[1]); w.y = cvt_pk(f[2], f[3]); w.z = cvt_pk(f[4], f[5]); w.w = cvt_pk(f[6], f[7]); return w; }
__device__ __forceinline__ float fast_rcp(float x) { return __builtin_amdgcn_rcpf(x); }
__device__ __forceinline__ float sigmoidf_(float x) { return fast_rcp(1.f + __expf(-x)); }
__device__ __forceinline__ float siluf_(float x) { return x * sigmoidf_(x); }
__device__ __forceinline__ float gelu_tanh(float v) { const float t = 1.5957691216057308f * (v + 0.044715f * v * v * v); return v * sigmoidf_(t); }
__device__ __forceinline__ float wave_sum(float v) {
#pragma unroll
    for (int o = 1; o < 64; o <<= 1) v += __shfl_xor(v, o);
    return v;
}
__device__ __forceinline__ int rfl(int v) { return __builtin_amdgcn_readfirstlane(v); }
typedef unsigned long long ss_t;
__device__ __forceinline__ float ss_load(const ss_t* p, size_t row) { return (float)(long long)p[row] * (1.f / 1048576.f); }
__device__ __forceinline__ ss_t ss_fix(float v) { return (ss_t)(long long)__float2ll_rn(v * 1048576.f); }
__device__ __forceinline__ void ss_add(ss_t* p, size_t row, float v) { atomicAdd(p + row, ss_fix(v)); }
__device__ __forceinline__ float opaque_zero() { float z = 0.f; asm volatile("" : "+v"(z)); return z; }
__device__ __forceinline__ unsigned opaque_zero_u() { unsigned z = 0u; asm volatile("" : "+v"(z)); return z; }

namespace pg8 {
constexpr int BM = 256, BK = 64, HALF = 128, HTB = HALF * BK * 2, STAGE_BYTES = 8 * HTB, NXCD = 8, WGM = 8;
__host__ __device__ __forceinline__ int lds_byte(int r, int c) { const int st = (r >> 4) * 2 + (c >> 5), rr = r & 15, cc = c & 31, ob = rr * 64 + cc * 2; return st * 1024 + (ob ^ (((ob >> 9) & 1) << 5)); }
__host__ __device__ __forceinline__ void stage_rc(int b, int& R, int& C) { const int st = b / 1024, sb = b % 1024, swz = sb ^ (((sb >> 9) & 1) << 5); R = (st >> 1) * 16 + swz / 64; C = (st & 1) * 32 + (swz % 64) / 2; }
__host__ __device__ __forceinline__ int perm32(int rho) { const int n = rho >> 4, i = rho & 15; return 8 * (i >> 2) + 4 * n + (i & 3); }

struct Unit { int pm, pn; };
struct Gemm { const bf16_t* A; const bf16_t* Bt; int lda, ldb, M, N, K; };

struct StaticOrder {
    int nM, nN, nwg, G, c;
    __device__ void init(int M_, int N_, int G_, int c_) { nM = M_ / BM; nN = N_ / BM; nwg = nM * nN; G = G_; c = c_; }
    __device__ bool next(int i, Unit& u) const {
        const long L = (long)i * G + c; if (L >= nwg) return false;
        int wgid = (int)L; { const int q = nwg / NXCD, r = nwg % NXCD, xcd = wgid % NXCD, off = wgid / NXCD; wgid = (xcd < r ? xcd * (q + 1) : r * (q + 1) + (xcd - r) * q) + off; }
        const int nig = WGM * nN, gid = wgid / nig, fm = gid * WGM, gsz = (nM - fm) < WGM ? (nM - fm) : WGM;
        u.pm = fm + ((wgid % nig) % gsz); u.pn = (wgid % nig) / gsz; return true;
    }
};

template <int N_, int K_, int LDA, int LDB, class Epi>
__device__ __forceinline__ void gemm_phase(LAS unsigned char* lds, const bf16_t* gA, const bf16_t* gBt, int G, int tid, const Epi& E) {
    asm volatile("" : "+v"(tid));
    StaticOrder S; S.init(32768, N_, G, (int)blockIdx.x);
    const int wid = __builtin_amdgcn_readfirstlane(tid >> 6), lane = tid & 63, wr = wid >> 2, wc = wid & 3, fr = lane & 15, fq = lane >> 4;
    constexpr int K = K_, nt = K / BK;
    struct { const bf16_t* A; const bf16_t* Bt; int lda, ldb; } g{gA, gBt, LDA, LDB};
    unsigned voffA[2], voffB[2];
#pragma unroll
    for (int i = 0; i < 2; ++i) { int R, C; stage_rc(tid * 16 + i * 8192, R, C); const int Rb = (R & ~31) + perm32(R & 31);
        voffA[i] = (unsigned)(R * g.lda + C) * 2u; voffB[i] = (unsigned)(Rb * g.ldb + C) * 2u; }
    const size_t kstep = (size_t)(BK * 2);
    const size_t hstepA = (size_t)HALF * g.lda * 2, hstepB = (size_t)HALF * g.ldb * 2;
    const size_t tstepA = 2 * hstepA, tstepB = 2 * hstepB;
    const unsigned ldsw = (unsigned)wid * 1024u;
    const int aoff = lds_byte(wr * 64 + fr, fq * 8), boff = lds_byte(wc * 32 + fr, fq * 8);
#define PG8_SA(b, h) (((b) * 2 + (h)) * HTB)
#define PG8_SB(b, h) ((4 + (b) * 2 + (h)) * HTB)
#define PG8_STAGE(bufoff, gbase, voff) do { _Pragma("unroll") for (int _i = 0; _i < 2; ++_i) \
        __builtin_amdgcn_global_load_lds((const unsigned*)((const char*)(gbase) + (voff)[_i]), (LAS unsigned*)(lds + (bufoff) + ldsw + _i * 8192), 16, 0, 0); } while (0)
#define PG8_LDA(dst, b, h) do { _Pragma("unroll") for (int m = 0; m < 4; ++m) _Pragma("unroll") for (int k = 0; k < 2; ++k) dst[m][k] = *(const LAS bf16x8*)(lds + PG8_SA(b, h) + aoff + m * 2048 + k * 1024); } while (0)
#define PG8_LDB(dst, b, h) do { _Pragma("unroll") for (int n = 0; n < 2; ++n) _Pragma("unroll") for (int k = 0; k < 2; ++k) dst[n][k] = *(const LAS bf16x8*)(lds + PG8_SB(b, h) + boff + n * 2048 + k * 1024); } while (0)
#define PG8_MMA(ai, bj, At, Bt) do { __builtin_amdgcn_s_setprio(1); _Pragma("unroll") for (int m = 0; m < 4; ++m) _Pragma("unroll") for (int n = 0; n < 2; ++n) _Pragma("unroll") for (int k = 0; k < 2; ++k) \
        acc[ai][bj][m][n] = __builtin_amdgcn_mfma_f32_16x16x32_bf16(Bt[n][k], At[m][k], acc[ai][bj][m][n], 0, 0, 0); __builtin_amdgcn_s_setprio(0); } while (0)
#define PG8_WAIT_V(n) asm volatile("s_waitcnt vmcnt(" #n ")" ::: "memory")
#define PG8_WAIT_L(n) asm volatile("s_waitcnt lgkmcnt(" #n ")" ::: "memory")
#define PG8_BAR __builtin_amdgcn_s_barrier()
#define PG8_SCHED __builtin_amdgcn_sched_barrier(0)
    Unit cur, nxt; int ui = 0;
    if (!S.next(0, cur)) return;
    const float zf = opaque_zero();
    f32x4 acc[2][2][4][2];
#pragma unroll
    for (int a = 0; a < 2; ++a)
#pragma unroll
        for (int b = 0; b < 2; ++b)
#pragma unroll
            for (int m = 0; m < 4; ++m)
#pragma unroll
                for (int n = 0; n < 2; ++n) acc[a][b][m][n] = (f32x4){zf, zf, zf, zf};
    bf16x8 At[4][2], B0[2][2], B1[2][2];
    typename Epi::Pre pre;
    const char* cA = (const char*)g.A + (size_t)cur.pm * tstepA; const char* cB = (const char*)g.Bt + (size_t)cur.pn * tstepB;
    PG8_STAGE(PG8_SB(0, 0), cB, voffB); PG8_STAGE(PG8_SB(0, 1), cB + hstepB, voffB); PG8_STAGE(PG8_SA(0, 0), cA, voffA); PG8_STAGE(PG8_SA(0, 1), cA + hstepA, voffA);
    if (wr == 1) PG8_BAR;
    PG8_WAIT_V(2); PG8_BAR;
    PG8_STAGE(PG8_SB(1, 0), cB + kstep, voffB); PG8_STAGE(PG8_SA(1, 0), cA + kstep, voffA); PG8_STAGE(PG8_SB(1, 1), cB + hstepB + kstep, voffB);
    PG8_WAIT_V(6); PG8_BAR;
    for (;;) {
        const bool has_next = S.next(ui + 1, nxt);
        const char* nA = has_next ? (const char*)g.A + (size_t)nxt.pm * tstepA : cA; const char* nB = has_next ? (const char*)g.Bt + (size_t)nxt.pn * tstepB : cB;
#pragma unroll 1
        for (int t = 0; t < nt; t += 2) {
            const bool last = (t == nt - 2);
            const char* a1 = cA + (size_t)(t + 1) * kstep;
            const char* a2 = last ? nA : cA + (size_t)(t + 2) * kstep; const char* b2 = last ? nB : cB + (size_t)(t + 2) * kstep;
            const char* a3 = a2 + kstep; const char* b3 = b2 + kstep;
            if (last) E.prefetch(pre, cur, wr, wc, fr, fq);
            PG8_LDB(B0, 0, 0); PG8_LDB(B1, 0, 1); PG8_SCHED; PG8_LDA(At, 0, 0); PG8_STAGE(PG8_SA(1, 1), a1 + hstepA, voffA);
            PG8_WAIT_V(8); PG8_WAIT_L(0); PG8_BAR; PG8_MMA(0, 0, At, B0); PG8_MMA(0, 1, At, B1); PG8_BAR; PG8_SCHED;
            PG8_LDA(At, 0, 1); PG8_STAGE(PG8_SB(0, 0), b2, voffB); PG8_STAGE(PG8_SB(0, 1), b2 + hstepB, voffB); PG8_STAGE(PG8_SA(0, 0), a2, voffA);
            PG8_WAIT_V(8); PG8_WAIT_L(0); PG8_BAR; PG8_MMA(1, 0, At, B0); PG8_MMA(1, 1, At, B1); PG8_BAR; PG8_SCHED;
            PG8_LDB(B0, 1, 0); PG8_LDB(B1, 1, 1); PG8_SCHED; PG8_LDA(At, 1, 0); PG8_STAGE(PG8_SA(0, 1), a2 + hstepA, voffA);
            PG8_WAIT_V(8); PG8_WAIT_L(0); PG8_BAR; PG8_MMA(0, 0, At, B0); PG8_MMA(0, 1, At, B1); PG8_BAR; PG8_SCHED;
            PG8_LDA(At, 1, 1); PG8_STAGE(PG8_SB(1, 0), b3, voffB); PG8_STAGE(PG8_SB(1, 1), b3 + hstepB, voffB); PG8_STAGE(PG8_SA(1, 0), a3, voffA);
            PG8_WAIT_V(8); PG8_WAIT_L(0); PG8_BAR; PG8_MMA(1, 0, At, B0); PG8_MMA(1, 1, At, B1); PG8_BAR; PG8_SCHED;
        }
        if (wr == 0) PG8_BAR;
        E(acc, cur, wr, wc, fr, fq, pre);
        if (!has_next) break;
#pragma unroll
        for (int a = 0; a < 2; ++a)
#pragma unroll
            for (int b = 0; b < 2; ++b)
#pragma unroll
                for (int m = 0; m < 4; ++m)
#pragma unroll
                    for (int n = 0; n < 2; ++n) acc[a][b][m][n] = (f32x4){zf, zf, zf, zf};
        cur = nxt; cA = nA; cB = nB; ++ui;
        if (wr == 1) PG8_BAR;
    }
    PG8_WAIT_V(0);
    PG8_BAR;
#undef PG8_SA
#undef PG8_SB
#undef PG8_STAGE
#undef PG8_LDA
#undef PG8_LDB
#undef PG8_MMA
#undef PG8_WAIT_V
#undef PG8_WAIT_L
#undef PG8_BAR
#undef PG8_SCHED
}

typedef f32x4 AccT[2][2][4][2];

struct EpiUp {
    bf16_t* O; const ss_t* ss;
    struct Pre { ss_t sv[4]; };
    __device__ __forceinline__ void prefetch(Pre& p, const Unit& u, int wr, int wc, int fr, int fq) const {
        const int row0 = u.pm * BM + wr * 64 + fr;
#pragma unroll
        for (int gi = 0; gi < 4; ++gi) p.sv[gi] = ss[row0 + (gi >> 2) * HALF + (gi & 3) * 16];
    }
    __device__ __forceinline__ void operator()(const AccT& acc, const Unit& u, int wr, int wc, int fr, int fq, const Pre& p) const {
        const int row0 = u.pm * BM + wr * 64 + fr, col0 = u.pn * 128 + wc * 32 + 8 * fq;
        ss_t sv[8];
#pragma unroll
        for (int gi = 0; gi < 4; ++gi) { sv[gi] = p.sv[gi]; sv[4 + gi] = ss[row0 + HALF + gi * 16]; }
#pragma unroll
        for (int gi = 0; gi < 8; ++gi) {
            const int ai = gi >> 2, m = gi & 3;
            const int row = row0 + ai * HALF + m * 16;
            const float rs = rsqrtf((float)(long long)sv[gi] * (1.f / 1048576.f) * (1.f / 1024.f) + EPS);
            float o[8];
#pragma unroll
            for (int n = 0; n < 2; ++n)
#pragma unroll
                for (int e = 0; e < 4; ++e) { const float gv = acc[ai][0][m][n][e] * rs, uv = acc[ai][1][m][n][e] * rs; o[4 * n + e] = siluf_(gv) * uv; }
            *(u32x4*)(O + (size_t)row * DFF + col0) = pack8(o);
        }
    }
};
struct EpiResid {
    bf16_t* xb; ss_t* ss_out; float alpha;
    struct Pre { u32x4 c[2]; };
    __device__ __forceinline__ void prefetch(Pre& p, const Unit& u, int wr, int wc, int fr, int fq) const {
        const int row0 = u.pm * BM + wr * 64 + fr, col0 = u.pn * BM + wc * 32 + 8 * fq;
#pragma unroll
        for (int bj = 0; bj < 2; ++bj) p.c[bj] = *(const u32x4*)(xb + (size_t)row0 * DM + col0 + bj * HALF);
    }
    __device__ __forceinline__ void operator()(const AccT& acc, const Unit& u, int wr, int wc, int fr, int fq, const Pre& p) const {
        const int row0 = u.pm * BM + wr * 64 + fr, col0 = u.pn * BM + wc * 32 + 8 * fq;
        u32x4 cur[2], nxt[2];
        cur[0] = p.c[0]; cur[1] = p.c[1];
#pragma unroll
        for (int gi = 0; gi < 8; ++gi) {
            const int ai = gi >> 2, m = gi & 3;
            const int row = row0 + ai * HALF + m * 16; float ssp = 0.f;
            if (gi + 1 < 8) { const int rown = row0 + ((gi + 1) >> 2) * HALF + ((gi + 1) & 3) * 16;
#pragma unroll
                for (int bj = 0; bj < 2; ++bj) nxt[bj] = *(const u32x4*)(xb + (size_t)rown * DM + col0 + bj * HALF); }
#pragma unroll
            for (int bj = 0; bj < 2; ++bj) {
                const size_t off = (size_t)row * DM + col0 + bj * HALF;
                float b[8]; unpack8(cur[bj], b);
                float v[8];
#pragma unroll
                for (int e = 0; e < 4; ++e) { v[e] = b[e] + acc[ai][bj][m][0][e] * alpha; v[4 + e] = b[4 + e] + acc[ai][bj][m][1][e] * alpha; }
                *(u32x4*)(xb + off) = pack8(v);
#pragma unroll
                for (int e = 0; e < 8; ++e) ssp += v[e] * v[e];
            }
            ssp += __shfl_xor(ssp, 16); ssp += __shfl_xor(ssp, 32);
            if (fq == 0) ss_add(ss_out, row, ssp);
            cur[0] = nxt[0]; cur[1] = nxt[1];
        }
    }
};
struct EpiScale {
    bf16_t* O; int ldc; const ss_t* ss_in; float inv_n; ss_t* ss_o0; ss_t* ss_o1; int sscode;
    struct Pre { int dummy; };
    __device__ __forceinline__ void prefetch(Pre&, const Unit&, int, int, int, int) const {}
    __device__ __forceinline__ void operator()(const AccT& acc, const Unit& u, int wr, int wc, int fr, int fq, const Pre&) const {
        const int row0 = u.pm * BM + wr * 64 + fr, col0 = u.pn * BM + wc * 32 + 8 * fq;
        ss_t sv[8];
#pragma unroll
        for (int gi = 0; gi < 8; ++gi) sv[gi] = ss_in ? ss_in[row0 + (gi >> 2) * HALF + (gi & 3) * 16] : (ss_t)0;
#pragma unroll
        for (int ai = 0; ai < 2; ++ai)
#pragma unroll
            for (int m = 0; m < 4; ++m) {
                const int row = row0 + ai * HALF + m * 16;
                const float rs = ss_in ? rsqrtf((float)(long long)sv[ai * 4 + m] * (1.f / 1048576.f) * inv_n + EPS) : 1.f;
#pragma unroll
                for (int bj = 0; bj < 2; ++bj) {
                    const f32x4 v0 = acc[ai][bj][m][0] * rs, v1 = acc[ai][bj][m][1] * rs;
                    u32x4 w; w.x = cvt_pk(v0[0], v0[1]); w.y = cvt_pk(v0[2], v0[3]); w.z = cvt_pk(v1[0], v1[1]); w.w = cvt_pk(v1[2], v1[3]);
                    *(u32x4*)(O + (size_t)row * ldc + col0 + bj * HALF) = w;
                    const int code = (sscode >> (2 * (u.pn * 2 + bj))) & 3;
                    if (code) {
                        float ssp = (v0[0] * v0[0] + v0[1] * v0[1]) + (v0[2] * v0[2] + v0[3] * v0[3]) + (v1[0] * v1[0] + v1[1] * v1[1]) + (v1[2] * v1[2] + v1[3] * v1[3]);
                        ssp += __shfl_xor(ssp, 16); ssp += __shfl_xor(ssp, 32);
                        if (fq == 0) ss_add(code == 1 ? ss_o0 : ss_o1, row, ssp);
                    }
                }
            }
    }
};
struct EpiKV {
    bf16_t* KB; bf16_t* VT; const ss_t* ss_in;
    struct Pre { int dummy; };
    __device__ __forceinline__ void prefetch(Pre&, const Unit&, int, int, int, int) const {}
    __device__ __forceinline__ void operator()(const AccT& acc, const Unit& u, int wr, int wc, int fr, int fq, const Pre&) const {
        const int row0 = u.pm * BM + wr * 64 + fr, c0 = wc * 32 + 8 * fq;
#pragma unroll
        for (int ai = 0; ai < 2; ++ai)
#pragma unroll
            for (int m = 0; m < 4; ++m) {
                const int row = row0 + ai * HALF + m * 16;
                {
                    const f32x4 v0 = acc[ai][0][m][0], v1 = acc[ai][0][m][1];
                    u32x4 w; w.x = cvt_pk(v0[0], v0[1]); w.y = cvt_pk(v0[2], v0[3]); w.z = cvt_pk(v1[0], v1[1]); w.w = cvt_pk(v1[2], v1[3]);
                    *(u32x4*)(KB + (size_t)row * 1536 + u.pn * 192 + c0) = w;
                }
                {
                    const f32x4 v0 = acc[ai][1][m][0], v1 = acc[ai][1][m][1];
                    const unsigned w[4] = {cvt_pk(v0[0], v0[1]), cvt_pk(v0[2], v0[3]), cvt_pk(v1[0], v1[1]), cvt_pk(v1[2], v1[3])};
                    { u32x4 ww; ww.x = w[0]; ww.y = w[1]; ww.z = w[2]; ww.w = w[3]; *(u32x4*)(VT + (size_t)row * 1024 + u.pn * 128 + c0) = ww; }
                }
            }
    }
};
struct EpiEvenIn {
    bf16_t* Z; float* LF; const ss_t* ss; const float* lb;
    struct Pre { ss_t sv[4]; };
    __device__ __forceinline__ void prefetch(Pre& p, const Unit& u, int wr, int wc, int fr, int fq) const {
        const int row0 = u.pm * BM + wr * 64 + fr;
#pragma unroll
        for (int gi = 0; gi < 4; ++gi) p.sv[gi] = ss[row0 + (gi >> 2) * HALF + (gi & 3) * 16];
    }
    __device__ __forceinline__ void operator()(const AccT& acc, const Unit& u, int wr, int wc, int fr, int fq, const Pre& p) const {
        const int row0 = u.pm * BM + wr * 64 + fr, col0 = u.pn * BM + wc * 32 + 8 * fq;
        const int kind = u.pn >> 1;
        ss_t sv[8];
#pragma unroll
        for (int gi = 0; gi < 4; ++gi) { sv[gi] = p.sv[gi]; sv[4 + gi] = ss[row0 + HALF + gi * 16]; }
#pragma unroll
        for (int ai = 0; ai < 2; ++ai)
#pragma unroll
            for (int m = 0; m < 4; ++m) {
                const int row = row0 + ai * HALF + m * 16;
                const float rs = rsqrtf((float)(long long)sv[ai * 4 + m] * (1.f / 1048576.f) * (1.f / 1024.f) + EPS);
#pragma unroll
                for (int bj = 0; bj < 2; ++bj) {
                    const int col = col0 + bj * HALF;
                    float v[8];
#pragma unroll
                    for (int e = 0; e < 4; ++e) { v[e] = acc[ai][bj][m][0][e] * rs; v[4 + e] = acc[ai][bj][m][1][e] * rs; }
                    if (kind == 3) {
                        const int cf = col - 1536;
                        f32x4 l0, l1;
#pragma unroll
                        for (int e = 0; e < 8; ++e) { const float lbv = lb[cf + e]; const float f = lbv + (1.f - lbv) * sigmoidf_(v[e]); const float lf = __logf(fmaxf(f, 1e-6f)); if (e < 4) l0[e] = lf; else l1[e - 4] = lf; }
                        *(f32x4*)(LF + (size_t)row * 512 + cf) = l0; *(f32x4*)(LF + (size_t)row * 512 + cf + 4) = l1;
                    } else {
                        if (kind <= 1) {
#pragma unroll
                            for (int e = 0; e < 8; ++e) v[e] = gelu_tanh(v[e]);
                        } else if (kind == 5) {
#pragma unroll
                            for (int e = 0; e < 8; ++e) v[e] = siluf_(v[e]);
                        }
                        const int dc = kind >= 4 ? col - 512 : col;
                        *(u32x4*)(Z + (size_t)row * 2560 + dc) = pack8(v);
                    }
                }
            }
    }
};
struct EpiPleG {
    const bf16_t* P; bf16_t* T; const ss_t* ss; ss_t* tss;
    struct Pre { ss_t sv[4]; };
    __device__ __forceinline__ void prefetch(Pre& p, const Unit& u, int wr, int wc, int fr, int fq) const {
        const int row0 = u.pm * BM + wr * 64 + fr, col0 = u.pn * BM + wc * 32 + 8 * fq;
#pragma unroll
        for (int gi = 0; gi < 4; ++gi) p.sv[gi] = ss[row0 + (gi >> 2) * HALF + (gi & 3) * 16];
    }
    __device__ __forceinline__ void operator()(const AccT& acc, const Unit& u, int wr, int wc, int fr, int fq, const Pre& p) const {
        const int row0 = u.pm * BM + wr * 64 + fr, col0 = u.pn * BM + wc * 32 + 8 * fq;
        ss_t sv[8];
#pragma unroll
        for (int gi = 0; gi < 4; ++gi) { sv[gi] = p.sv[gi]; sv[4 + gi] = ss[row0 + HALF + gi * 16]; }
        u32x4 cur[2], nxt[2];
#pragma unroll
        for (int bj = 0; bj < 2; ++bj) cur[bj] = *(const u32x4*)(P + (size_t)row0 * DM + col0 + bj * HALF);
#pragma unroll
        for (int gi = 0; gi < 8; ++gi) {
            const int ai = gi >> 2, m = gi & 3;
            const int row = row0 + ai * HALF + m * 16; float ssp = 0.f;
            if (gi + 1 < 8) { const int rown = row0 + ((gi + 1) >> 2) * HALF + ((gi + 1) & 3) * 16;
#pragma unroll
                for (int bj = 0; bj < 2; ++bj) nxt[bj] = *(const u32x4*)(P + (size_t)rown * DM + col0 + bj * HALF); }
            const float rs = rsqrtf((float)(long long)sv[gi] * (1.f / 1048576.f) * (1.f / 1024.f) + EPS);
#pragma unroll
            for (int bj = 0; bj < 2; ++bj) {
                const size_t off = (size_t)row * DM + col0 + bj * HALF;
                float pv[8]; unpack8(cur[bj], pv);
                float t[8];
#pragma unroll
                for (int e = 0; e < 4; ++e) { t[e] = sigmoidf_(acc[ai][bj][m][0][e] * rs) * pv[e]; t[4 + e] = sigmoidf_(acc[ai][bj][m][1][e] * rs) * pv[4 + e]; }
#pragma unroll
                for (int e = 0; e < 8; ++e) ssp += t[e] * t[e];
                *(u32x4*)(T + off) = pack8(t);
            }
            ssp += __shfl_xor(ssp, 16); ssp += __shfl_xor(ssp, 32);
            if (fq == 0) ss_add(tss, row, ssp);
            cur[0] = nxt[0]; cur[1] = nxt[1];
        }
    }
};
}

struct Args { const void* in[24]; float* out; unsigned char* ws; int ph_lo, ph_hi; };


__device__ __forceinline__ void tr_item(const float* __restrict__ W, int ldw, int col0, int k0, const float* __restrict__ gain, bf16_t* WT, int ldt, int drow0, bool zero, LAS float* scr, int lane) {
    const int c = lane & 7;
    if (zero) {
#pragma unroll
        for (int j = 0; j < 4; ++j) { const int n = (lane >> 3) + 8 * j; const unsigned zu = opaque_zero_u(); *(u32x4*)(WT + (size_t)(drow0 + n) * ldt + k0 + 8 * c) = (u32x4){zu, zu, zu, zu}; }
        return;
    }
    float wv[32];
    const float* wp = W + (size_t)(k0 + (lane >> 5)) * ldw + col0 + (lane & 31);
#pragma unroll
    for (int i = 0; i < 32; ++i) wv[i] = wp[(size_t)(2 * i) * ldw];
    const float gl = gain ? gain[k0 + lane] : 1.f;
#pragma unroll
    for (int i = 0; i < 32; ++i) { const int kk = 2 * i + (lane >> 5); scr[kk * 33 + (lane & 31)] = wv[i] * __shfl(gl, kk); }
    asm volatile("s_waitcnt lgkmcnt(0)" ::: "memory");
#pragma unroll
    for (int j = 0; j < 4; ++j) { const int n = (lane >> 3) + 8 * j; const LAS float* s = scr + (8 * c) * 33 + n;
        u32x4 o; o.x = cvt_pk(s[0 * 33], s[1 * 33]); o.y = cvt_pk(s[2 * 33], s[3 * 33]); o.z = cvt_pk(s[4 * 33], s[5 * 33]); o.w = cvt_pk(s[6 * 33], s[7 * 33]);
        *(u32x4*)(WT + (size_t)(drow0 + n) * ldt + k0 + 8 * c) = o; }
    asm volatile("s_waitcnt lgkmcnt(0)" ::: "memory");
}

__device__ __forceinline__ void p0_prologue(const Args& a, LAS unsigned char* lds, int tid, int lane, int wave, int G, int bx, size_t zo) {
    unsigned char* ws = a.ws + zo;
    LAS float* scr = (LAS float*)(lds + wave * 8704);
    const int gw = blockIdx.x * 8 + wave, NGW = G * 8;
    const float* ng = (const float*)a.in[3];
    constexpr int L_ITEMS = 9088, N_L = 4 * L_ITEMS, E_ITEMS = 2048, O_ITEMS = 1440, NITEMS = N_L + 2 * E_ITEMS + 2 * O_ITEMS;
    for (int it0 = gw; it0 < NITEMS; it0 += NGW) {
        int it = it0;
        const float* W; int ldw, col0, k0, ldt, drow0; const float* gain = nullptr; bf16_t* WT; bool zero = false;
        if (it < N_L) {
            const int i = it / L_ITEMS; int r = it % L_ITEMS; unsigned char* wl = ws + WS_W + (size_t)i * LW_STRIDE;
            if (r < 8448) {
                const int f = r / 4224; r %= 4224;
                if (r < 2816) { const int kb = r / 176, nb = r % 176, tile = nb >> 3, cb = nb & 7;
                    W = (const float*)a.in[cb < 4 ? 4 : 5] + (size_t)(i * 2 + f) * DM * DFF; ldw = DFF; col0 = tile * 128 + (cb & 3) * 32; k0 = kb * 64;
                    gain = ng + (i * 5 + (f ? 2 : 0)) * 1024; WT = (bf16_t*)(wl + (f ? OFF_WUP1 : OFF_WUP0)); ldt = 1024; drow0 = nb * 32;
                } else { r -= 2816; const int kb = r / 32, nb = r % 32;
                    W = (const float*)a.in[6] + (size_t)(i * 2 + f) * DFF * DM; ldw = DM; col0 = nb * 32; k0 = kb * 64; WT = (bf16_t*)(wl + (f ? OFF_WDN1 : OFF_WDN0)); ldt = DFF; drow0 = nb * 32; }
            } else { r -= 8448;
                if (r < 512) { const int kb = r / 32, nb = r % 32; W = (const float*)a.in[7] + (size_t)i * DM * DM; ldw = DM; col0 = nb * 32; k0 = kb * 64; gain = ng + (i * 5 + 3) * 1024; WT = (bf16_t*)(wl + OFF_WPG); ldt = 1024; drow0 = nb * 32; }
                else { r -= 512; const int kb = r / 32, nb = r % 32; W = (const float*)a.in[8] + (size_t)i * 256 * DM; ldw = DM; col0 = nb * 32; k0 = kb * 64; WT = (bf16_t*)(wl + OFF_WPP); ldt = 256; drow0 = nb * 32; }
            }
        } else {
            it -= N_L;
            if (it < 2 * E_ITEMS) { const int j = it / E_ITEMS; int r = it % E_ITEMS; unsigned char* we = ws + WS_WE + (size_t)j * WE_STRIDE;
                if (r < 1536) { const int kb = r / 96, nb = r % 96; W = (const float*)a.in[9] + (size_t)j * DM * 3072; ldw = 3072; col0 = nb * 32; k0 = kb * 64; gain = ng + ((2 * j) * 5 + 1) * 1024; WT = (bf16_t*)(we + OFF_WEIN); ldt = 1024; drow0 = nb * 32; }
                else { r -= 1536; const int kb = r / 32, nb = r % 32; W = (const float*)a.in[15] + (size_t)j * DM * DM; ldw = DM; col0 = nb * 32; k0 = kb * 64; WT = (bf16_t*)(we + OFF_WEOUT); ldt = 1024; drow0 = nb * 32; }
            } else { it -= 2 * E_ITEMS; const int j = it / O_ITEMS; int r = it % O_ITEMS; unsigned char* wo = ws + WS_WO + (size_t)j * WO_STRIDE;
                if (r < 384) { const int kb = r / 24, nb = r % 24; zero = nb >= 22; W = (const float*)a.in[16] + (size_t)j * DM * 704; ldw = 704; col0 = nb * 32; k0 = kb * 64; gain = ng + ((2 * j + 1) * 5 + 1) * 1024; WT = (bf16_t*)(wo + OFF_WMIN); ldt = 1024; drow0 = nb * 32; }
                else if ((r -= 384) < 288) { const int kb = r / 48, nb = r % 48; W = (const float*)a.in[19] + (size_t)j * 384 * 1536; ldw = 1536; col0 = nb * 32; k0 = kb * 64; gain = (const float*)a.in[17] + j * 384; WT = (bf16_t*)(wo + OFF_WQB); ldt = 384; drow0 = nb * 32; }
                else if ((r -= 288) < 256) { const int kb = r / 64, nb = r % 64; W = (const float*)a.in[20] + (size_t)j * 256 * 2048; ldw = 2048; col0 = nb * 32; k0 = kb * 64; gain = (const float*)a.in[18] + j * 256; WT = (bf16_t*)(wo + OFF_WKVB); ldt = 256; drow0 = nb * 32; }
                else { r -= 256; const int kb = r / 32, nb = r % 32; W = (const float*)a.in[23] + (size_t)j * DM * DM; ldw = DM; col0 = nb * 32; k0 = kb * 64; WT = (bf16_t*)(wo + OFF_WMOUT); ldt = 1024; drow0 = nb * 32; }
            }
        }
        tr_item(W, ldw, col0, k0, gain, WT, ldt, drow0, zero, scr, lane);
    }
    {
        const float* x = (const float*)a.in[0]; bf16_t* XB = (bf16_t*)(ws + WS_XB); ss_t* SS = (ss_t*)(ws + WS_SS);
        for (int row = gw; row < M; row += NGW) {
            float ssp = 0.f;
#pragma unroll
            for (int j = 0; j < 2; ++j) { const int c = lane + 64 * j; const size_t off = (size_t)row * DM + 8 * c;
                const f32x4 v0 = *(const f32x4*)(x + off), v1 = *(const f32x4*)(x + off + 4);
                u32x4 w; w.x = cvt_pk(v0[0], v0[1]); w.y = cvt_pk(v0[2], v0[3]); w.z = cvt_pk(v1[0], v1[1]); w.w = cvt_pk(v1[2], v1[3]);
                *(u32x4*)(XB + off) = w;
                ssp += (v0[0] * v0[0] + v0[1] * v0[1]) + (v0[2] * v0[2] + v0[3] * v0[3]) + (v1[0] * v1[0] + v1[1] * v1[1]) + (v1[2] * v1[2] + v1[3] * v1[3]); }
            ssp = wave_sum(ssp);
            if (lane == 0) SS[row] = ss_fix(ssp);
        }
        f32x4* z = (f32x4*)(SS + M);
        for (size_t i = (size_t)blockIdx.x * 512 + tid; i < (size_t)28 * M / 2; i += (size_t)G * 512) { const float zz = opaque_zero(); z[i] = (f32x4){zz, zz, zz, zz}; }
        if (blockIdx.x == 0) { const float* lr = (const float*)a.in[13]; float* LB = (float*)(ws + WS_LB);
            const float r0 = lr[tid], r1 = lr[512 + tid]; const float sm1 = 1.f / (1.f + expf(r0 - r1));
            LB[tid] = 0.f; LB[512 + tid] = fminf(fmaxf(sm1, 0.f), 0.999f); }
    }
}

__device__ __forceinline__ void p_convert(const float* p, bf16_t* PB, int tid, int G) {
    for (size_t i = (size_t)blockIdx.x * 512 + tid; i < (size_t)M * 256 / 8; i += (size_t)G * 512) {
        const f32x4 v0 = *(const f32x4*)(p + i * 8), v1 = *(const f32x4*)(p + i * 8 + 4);
        u32x4 w; w.x = cvt_pk(v0[0], v0[1]); w.y = cvt_pk(v0[2], v0[3]); w.z = cvt_pk(v1[0], v1[1]); w.w = cvt_pk(v1[2], v1[3]);
        *(u32x4*)(PB + i * 8) = w;
    }
}
__device__ __forceinline__ void ple_finalize(float* xout, const bf16_t* T, const ss_t* tss, const float* g4, bf16_t* XB, ss_t* ssn, int lane, int wave, int G) {
    const int gw = blockIdx.x * 8 + wave, NGW = G * 8;
    f32x4 gg[2][2];
#pragma unroll
    for (int j = 0; j < 2; ++j) { const int c = lane + 64 * j; gg[j][0] = *(const f32x4*)(g4 + 8 * c); gg[j][1] = *(const f32x4*)(g4 + 8 * c + 4); }
    for (int row = gw; row < M; row += 2 * NGW) {
        u32x4 tv[2][2], xv[2][2]; ss_t sv[2];
#pragma unroll
        for (int r = 0; r < 2; ++r) { const int rr = row + r * NGW; sv[r] = tss[rr];
#pragma unroll
            for (int j = 0; j < 2; ++j) { const int c = lane + 64 * j; const size_t off = (size_t)rr * DM + 8 * c; tv[r][j] = *(const u32x4*)(T + off); xv[r][j] = *(const u32x4*)(XB + off); } }
#pragma unroll
        for (int r = 0; r < 2; ++r) { const int rr = row + r * NGW;
            const float rs = rsqrtf((float)(long long)sv[r] * (1.f / 1048576.f) * (1.f / 1024.f) + EPS); float ssp = 0.f;
#pragma unroll
            for (int j = 0; j < 2; ++j) { const int c = lane + 64 * j; const size_t off = (size_t)rr * DM + 8 * c;
                float t[8], v[8]; unpack8(tv[r][j], t); unpack8(xv[r][j], v);
#pragma unroll
                for (int e = 0; e < 4; ++e) { v[e] += t[e] * rs * gg[j][0][e]; v[4 + e] += t[4 + e] * rs * gg[j][1][e]; }
                if (xout) { *(f32x4*)(xout + off) = (f32x4){v[0], v[1], v[2], v[3]}; *(f32x4*)(xout + off + 4) = (f32x4){v[4], v[5], v[6], v[7]}; }
                *(u32x4*)(XB + off) = pack8(v);
#pragma unroll
                for (int e = 0; e < 8; ++e) ssp += v[e] * v[e]; }
            ssp = wave_sum(ssp);
            if (lane == 0) ssn[rr] = ss_fix(ssp); }
    }
}

__device__ __forceinline__ void gmlp_unit(LAS unsigned char* lds, int unit, const bf16_t* Z, const float* w_s, const float* b_s, const float* vnorm, bf16_t* MIX, int tid, bool stage_w) {
    asm volatile("" : "+v"(tid));
    const int h = unit & 7, bc = unit >> 3;
    const size_t row0 = (size_t)bc * 128;
    LAS bf16_t* Wb = (LAS bf16_t*)lds;
    LAS bf16_t* VnT = (LAS bf16_t*)(lds + 34816);
    const int lane = tid & 63, wave = rfl(tid >> 6), fr = lane & 15, fq = lane >> 4;
    {
        const int s = tid >> 2, part = tid & 3;
        const bf16_t* vp = Z + (row0 + s) * 2560 + 512 + h * 64 + part * 16;
        float v[16]; unpack8(*(const u32x4*)vp, v); unpack8(*(const u32x4*)(vp + 8), v + 8);
        float ssp = 0.f;
#pragma unroll
        for (int e = 0; e < 16; ++e) ssp += v[e] * v[e];
        ssp += __shfl_xor(ssp, 1); ssp += __shfl_xor(ssp, 2);
        const float rs = rsqrtf(ssp * (1.f / 64.f) + EPS);
#pragma unroll
        for (int e = 0; e < 16; e += 2) { const unsigned w = cvt_pk(v[e] * rs * vnorm[h * 64 + part * 16 + e], v[e + 1] * rs * vnorm[h * 64 + part * 16 + e + 1]);
            VnT[(part * 16 + e) * 136 + s] = (bf16_t)(w & 0xffffu); VnT[(part * 16 + e + 1) * 136 + s] = (bf16_t)(w >> 16); }
        if (stage_w) {
            const f32x4* wp = (const f32x4*)(w_s + (size_t)h * 128 * 128);
            f32x4 wv[8];
#pragma unroll
            for (int k = 0; k < 8; ++k) wv[k] = wp[tid + 512 * k];
#pragma unroll
            for (int k = 0; k < 8; ++k) { const int i4 = (tid + 512 * k) * 4, t = i4 >> 7, s2 = i4 & 127;
                u32x2 w; w.x = cvt_pk(s2 <= t ? wv[k][0] : 0.f, s2 + 1 <= t ? wv[k][1] : 0.f); w.y = cvt_pk(s2 + 2 <= t ? wv[k][2] : 0.f, s2 + 3 <= t ? wv[k][3] : 0.f);
                *(LAS u32x2*)(Wb + t * 136 + s2) = w; }
        }
    }
    __syncthreads();
    {
        f32x4 acc[4];
#pragma unroll
        for (int nt = 0; nt < 4; ++nt) acc[nt] = (f32x4){0.f, 0.f, 0.f, 0.f};
#pragma unroll
        for (int ks = 0; ks < 4; ++ks) {
            if (32 * ks <= 16 * wave + 15) {
                const bf16x8 bv = *(const LAS bf16x8*)(Wb + (16 * wave + fr) * 136 + 32 * ks + 8 * fq);
#pragma unroll
                for (int nt = 0; nt < 4; ++nt) {
                    const bf16x8 av = *(const LAS bf16x8*)(VnT + (16 * nt + fr) * 136 + 32 * ks + 8 * fq);
                    acc[nt] = __builtin_amdgcn_mfma_f32_16x16x32_bf16(av, bv, acc[nt], 0, 0, 0);
                }
            }
        }
        const int t = 16 * wave + fr;
        const float bias = b_s[h * 128 + t];
#pragma unroll
        for (int nt = 0; nt < 4; ++nt) {
            const int e0 = 16 * nt + 4 * fq;
            const u32x2 uw = *(const u32x2*)(Z + (row0 + t) * 2560 + h * 64 + e0);
            const float o0 = bf_lo(uw.x) * (acc[nt][0] + bias), o1 = bf_hi(uw.x) * (acc[nt][1] + bias), o2 = bf_lo(uw.y) * (acc[nt][2] + bias), o3 = bf_hi(uw.y) * (acc[nt][3] + bias);
            u32x2 ow; ow.x = cvt_pk(o0, o1); ow.y = cvt_pk(o2, o3);
            *(u32x2*)(MIX + (row0 + t) * DM + h * 64 + e0) = ow;
        }
    }
    __syncthreads();
}

__device__ __forceinline__ bf16_t f2bf(float x) { return (bf16_t)(cvt_pk(x, 0.f) & 0xffffu); }
#define HBAR() asm volatile("s_waitcnt lgkmcnt(0)\n\ts_barrier" ::: "memory")
__device__ __forceinline__ void hgrn_unit(LAS unsigned char* lds, int unit, const bf16_t* Z, const float* LF, bf16_t* OH, int tid, int lane, int wave) {
    asm volatile("" : "+v"(tid));
    lane = tid & 63;
    const int es = unit & 7, h = (unit >> 3) & 3, b = unit >> 5;
    LAS float* LFs = (LAS float*)lds;
    LAS bf16_t* Qs = (LAS bf16_t*)(lds + 32768);
    LAS bf16_t* Aq = (LAS bf16_t*)(lds + 49152);
    LAS bf16_t* Bk = (LAS bf16_t*)(lds + 66560);
    LAS bf16_t* Aqe = (LAS bf16_t*)(lds + 83968);
    LAS bf16_t* KKt = (LAS bf16_t*)(lds + 101376);
    LAS bf16_t* Vt = (LAS bf16_t*)(lds + 119808);
    LAS bf16_t* Pm = (LAS bf16_t*)(lds + 122112);
    LAS bf16_t* St = (LAS bf16_t*)(lds + 131328);
    LAS float* Gs = (LAS float*)(lds + 135680);
    LAS float* QS = (LAS float*)(lds + 136192);
    const int fr = lane & 15, fq = lane >> 4;
    for (int i = tid; i < 16 * 136 / 2; i += 512) ((LAS unsigned*)St)[i] = 0u;
    f32x4 st = (f32x4){0.f, 0.f, 0.f, 0.f};
    const int lt = tid >> 3, lpart = tid & 7;
    const int vt2 = tid >> 1, vpp = tid & 1;
    const int cd = tid & 127, ctq = tid >> 7;
    const size_t rowb = (size_t)b * SEQ;
    f32x4 plf[4]; u32x4 pq[2]; u32x4 pv = (u32x4){0u, 0u, 0u, 0u};
    {
        const float* lp = LF + (rowb + lt) * 512 + h * 128 + lpart * 16;
        const bf16_t* qp = Z + (rowb + lt) * 2560 + 1024 + h * 128 + lpart * 16;
#pragma unroll
        for (int j = 0; j < 4; ++j) plf[j] = *(const f32x4*)(lp + 4 * j);
        pq[0] = *(const u32x4*)qp; pq[1] = *(const u32x4*)(qp + 8);
        if (tid < 128) pv = *(const u32x4*)(Z + (rowb + vt2) * 2560 + 1536 + h * 128 + es * 16 + vpp * 8);
    }
#pragma unroll 1
    for (int c = 0; c < SEQ / 64; ++c) {
        const size_t row0 = rowb + (size_t)c * 64;
#pragma unroll
        for (int j = 0; j < 4; ++j) *(LAS f32x4*)(LFs + lt * 128 + lpart * 16 + 4 * j) = plf[j];
        *(LAS u32x4*)(Qs + lt * 128 + lpart * 16) = pq[0]; *(LAS u32x4*)(Qs + lt * 128 + lpart * 16 + 8) = pq[1];
        if (tid < 128) { const unsigned ww[4] = {pv.x, pv.y, pv.z, pv.w};
#pragma unroll
            for (int j = 0; j < 4; ++j) { Vt[(vpp * 8 + 2 * j) * 72 + vt2] = (bf16_t)(ww[j] & 0xffffu); Vt[(vpp * 8 + 2 * j + 1) * 72 + vt2] = (bf16_t)(ww[j] >> 16); } }
        HBAR();
        if (c + 1 < SEQ / 64) {
            const float* lp = LF + (row0 + 64 + lt) * 512 + h * 128 + lpart * 16;
            const bf16_t* qp = Z + (row0 + 64 + lt) * 2560 + 1024 + h * 128 + lpart * 16;
#pragma unroll
            for (int j = 0; j < 4; ++j) plf[j] = *(const f32x4*)(lp + 4 * j);
            pq[0] = *(const u32x4*)qp; pq[1] = *(const u32x4*)(qp + 8);
            if (tid < 128) pv = *(const u32x4*)(Z + (row0 + 64 + vt2) * 2560 + 1536 + h * 128 + es * 16 + vpp * 8);
        }
        float L[16]; float run = 0.f;
#pragma unroll
        for (int i = 0; i < 16; ++i) { run += LFs[(16 * ctq + i) * 128 + cd]; L[i] = run; }
        QS[ctq * 128 + cd] = run;
        HBAR();
        {
            const float q0 = QS[cd], q1 = QS[128 + cd], q2 = QS[256 + cd], q3 = QS[384 + cd];
            const float bref = q0 + q1, tot = (q0 + q1) + (q2 + q3);
            const float off = ctq == 0 ? 0.f : ctq == 1 ? q0 : ctq == 2 ? q0 + q1 : (q0 + q1) + q2;
            unsigned kkp[8];
            float lfv[16], qvv[16];
#pragma unroll
            for (int i = 0; i < 16; ++i) { const int t = 16 * ctq + i; lfv[i] = LFs[t * 128 + cd]; qvv[i] = bf_lo((unsigned)Qs[t * 128 + cd]); }
            const float ebref = __expf(bref), etb = __expf(tot - bref);
#pragma unroll
            for (int i = 0; i < 16; ++i) {
                const int t = 16 * ctq + i;
                const float B = L[i] + off;
                const float E = __expf(B - bref), Ei = fast_rcp(E);
                const float kv = 1.f - __expf(lfv[i]);
                Aq[t * 136 + cd] = f2bf(qvv[i] * E);
                Bk[t * 136 + cd] = f2bf(kv * Ei);
                Aqe[t * 136 + cd] = f2bf(qvv[i] * E * ebref);
                L[i] = kv * Ei * etb;
            }
#pragma unroll
            for (int i = 0; i < 8; ++i) kkp[i] = cvt_pk(L[2 * i], L[2 * i + 1]);
            *(LAS u32x4*)(KKt + cd * 72 + 16 * ctq) = (u32x4){kkp[0], kkp[1], kkp[2], kkp[3]};
            *(LAS u32x4*)(KKt + cd * 72 + 16 * ctq + 8) = (u32x4){kkp[4], kkp[5], kkp[6], kkp[7]};
            if (ctq == 0) Gs[cd] = __expf(tot);
        }
        HBAR();
        {
            const int tb = wave & 3, sbp = wave >> 2;
#pragma unroll
            for (int k2 = 0; k2 < 2; ++k2) {
                const int sb = 2 * sbp + k2;
                f32x4 acc = (f32x4){0.f, 0.f, 0.f, 0.f};
                if (sb <= tb) {
#pragma unroll
                    for (int ks = 0; ks < 4; ++ks) {
                        const bf16x8 av = *(const LAS bf16x8*)(Aq + (16 * tb + fr) * 136 + 32 * ks + 8 * fq);
                        const bf16x8 bv = *(const LAS bf16x8*)(Bk + (16 * sb + fr) * 136 + 32 * ks + 8 * fq);
                        acc = __builtin_amdgcn_mfma_f32_16x16x32_bf16(av, bv, acc, 0, 0, 0);
                    }
                    if (sb == tb) {
#pragma unroll
                        for (int i = 0; i < 4; ++i) if (fr > 4 * fq + i) acc[i] = 0.f;
                    }
                }
#pragma unroll
                for (int i = 0; i < 4; ++i) Pm[(16 * tb + 4 * fq + i) * 72 + 16 * sb + fr] = f2bf(acc[i]);
            }
        }
        HBAR();
        if (wave < 4) {
            const int tb = wave;
            f32x4 acc = (f32x4){0.f, 0.f, 0.f, 0.f};
#pragma unroll
            for (int ks = 0; ks < 2; ++ks) {
                const bf16x8 av = *(const LAS bf16x8*)(Pm + (16 * tb + fr) * 72 + 32 * ks + 8 * fq);
                const bf16x8 bv = *(const LAS bf16x8*)(Vt + fr * 72 + 32 * ks + 8 * fq);
                acc = __builtin_amdgcn_mfma_f32_16x16x32_bf16(av, bv, acc, 0, 0, 0);
            }
#pragma unroll
            for (int ks = 0; ks < 4; ++ks) {
                const bf16x8 av = *(const LAS bf16x8*)(Aqe + (16 * tb + fr) * 136 + 32 * ks + 8 * fq);
                const bf16x8 bv = *(const LAS bf16x8*)(St + fr * 136 + 32 * ks + 8 * fq);
                acc = __builtin_amdgcn_mfma_f32_16x16x32_bf16(av, bv, acc, 0, 0, 0);
            }
#pragma unroll
            for (int i = 0; i < 4; ++i) OH[(row0 + 16 * tb + 4 * fq + i) * 512 + h * 128 + es * 16 + fr] = f2bf(acc[i]);
        }
        {
            const f32x4 g = *(const LAS f32x4*)(Gs + 16 * wave + 4 * fq);
            st = st * g;
#pragma unroll
            for (int ks = 0; ks < 2; ++ks) {
                const bf16x8 av = *(const LAS bf16x8*)(KKt + (16 * wave + fr) * 72 + 32 * ks + 8 * fq);
                const bf16x8 bv = *(const LAS bf16x8*)(Vt + fr * 72 + 32 * ks + 8 * fq);
                st = __builtin_amdgcn_mfma_f32_16x16x32_bf16(av, bv, st, 0, 0, 0);
            }
        }
        HBAR();
        { u32x2 w; w.x = cvt_pk(st[0], st[1]); w.y = cvt_pk(st[2], st[3]); *(LAS u32x2*)(St + fr * 136 + 16 * wave + 4 * fq) = w; }
    }
    HBAR();
}
#undef HBAR
__device__ __forceinline__ void hgrn_onorm(const bf16_t* OH, const bf16_t* Z, const float* gain, bf16_t* MIX, int lane, int wave, int G) {
    const int gw = blockIdx.x * 8 + wave, NGW = G * 8;
    const int e0 = (8 * lane) & 127;
    const f32x4 g0 = *(const f32x4*)(gain + e0), g1 = *(const f32x4*)(gain + e0 + 4);
    for (int row = gw; row < M; row += 2 * NGW) {
        u32x4 ov[2], zv[2];
#pragma unroll
        for (int r = 0; r < 2; ++r) { const size_t rr = (size_t)(row + r * NGW); ov[r] = *(const u32x4*)(OH + rr * 512 + 8 * lane); zv[r] = *(const u32x4*)(Z + rr * 2560 + 2048 + 8 * lane); }
#pragma unroll
        for (int r = 0; r < 2; ++r) { const size_t rr = (size_t)(row + r * NGW);
            float v[8]; unpack8(ov[r], v);
            float ssp = 0.f;
#pragma unroll
            for (int e = 0; e < 8; ++e) ssp += v[e] * v[e];
            ssp += __shfl_xor(ssp, 1); ssp += __shfl_xor(ssp, 2); ssp += __shfl_xor(ssp, 4); ssp += __shfl_xor(ssp, 8);
            const float rs = rsqrtf(ssp * (1.f / 128.f) + EPS);
            float sg[8]; unpack8(zv[r], sg);
            float o[8];
#pragma unroll
            for (int e = 0; e < 4; ++e) { o[e] = v[e] * rs * g0[e] * sg[e]; o[4 + e] = v[4 + e] * rs * g1[e] * sg[4 + e]; }
            *(u32x4*)(MIX + rr * DM + 512 + 8 * lane) = pack8(o); }
    }
}

constexpr float QSCALE = 0.07216878364870323f * 1.4426950408889634f;
__device__ __forceinline__ void mla_prep_unit(LAS unsigned char* lds, int tb, bf16_t* Q, bf16_t* KV, const bf16_t* ZC, bf16_t* VT, const int* positions, const float* qnorm, const float* knorm, int tid, int lane, int wave) {
    asm volatile("" : "+v"(tid));
    lane = tid & 63;
    const size_t r0 = (size_t)tb * 64; const int b = (int)(r0 / SEQ), s0 = (int)(r0 % SEQ);
    LAS float* RS = (LAS float*)lds;
    {
        const int tok = tid >> 3, part = tid & 7;
        const bf16_t* cp = ZC + (r0 + tok) * 768 + 384 + part * 32;
        float ssp = 0.f;
#pragma unroll
        for (int c = 0; c < 4; ++c) { float v[8]; unpack8(*(const u32x4*)(cp + 8 * c), v);
#pragma unroll
            for (int j = 0; j < 8; ++j) ssp += v[j] * v[j]; }
        ssp += __shfl_xor(ssp, 1); ssp += __shfl_xor(ssp, 2); ssp += __shfl_xor(ssp, 4);
        if (part == 0) RS[tok] = rsqrtf(ssp * (1.f / 256.f) + EPS);
    }
    __syncthreads();
#pragma unroll 4
    for (int k = 0; k < 16; ++k) {
        const int ci = tid + 512 * k, tok = ci >> 7, c8 = (ci & 127) * 8;
        bf16_t* vp = VT + (r0 + tok) * 1024 + c8;
        float v[8]; unpack8(*(const u32x4*)vp, v);
        const float rk = RS[tok];
#pragma unroll
        for (int j = 0; j < 8; ++j) v[j] *= rk;
        *(u32x4*)vp = pack8(v);
    }
    const int half = lane >> 5, rl = lane & 31; const bool act = rl < 24;
    const float invf = exp2f(-(float)rl * 0.4152410118609203f);
    float qg[8], kg[8];
#pragma unroll
    for (int j = 0; j < 8; ++j) { qg[j] = act ? qnorm[8 * rl + j] : 0.f; kg[j] = act ? knorm[8 * rl + j] : 0.f; }
    const bool ropeA = (rl >= 16 && rl < 20), ropeB = (rl >= 20 && rl < 24);
    const int rla = act ? rl : 0;
    u32x4 qc[4], kc[4], qn[4], kn[4]; int pc, pn;
    {
        const size_t row = r0 + wave * 8;
        pc = positions[row];
#pragma unroll
        for (int hp = 0; hp < 4; ++hp) { const int head = 2 * hp + half;
            qc[hp] = *(const u32x4*)(Q + row * 1536 + head * 192 + 8 * rla);
            kc[hp] = (rl >= 16 && act) ? *(const u32x4*)(ZC + row * 768 + 640 + 8 * (rl - 16)) : *(const u32x4*)(KV + row * 1536 + head * 192 + 8 * rla); }
    }
    pn = pc;
#pragma unroll
    for (int hp = 0; hp < 4; ++hp) { qn[hp] = qc[hp]; kn[hp] = kc[hp]; }
#pragma unroll 1
    for (int rr = 0; rr < 8; ++rr) {
        const size_t row = r0 + wave * 8 + rr;
        if (rr + 1 < 8) {
            const size_t rown = row + 1;
            pn = positions[rown];
#pragma unroll
            for (int hp = 0; hp < 4; ++hp) { const int head = 2 * hp + half;
                qn[hp] = *(const u32x4*)(Q + rown * 1536 + head * 192 + 8 * rla);
                kn[hp] = (rl >= 16 && act) ? *(const u32x4*)(ZC + rown * 768 + 640 + 8 * (rl - 16)) : *(const u32x4*)(KV + rown * 1536 + head * 192 + 8 * rla); }
        }
        const float ang = (float)pc * invf;
        float sn, cs; sincosf(ang, &sn, &cs);
        float cv[8], sv[8];
#pragma unroll
        for (int j = 0; j < 8; ++j) { const int src = (lane & 32) + 8 * (rl & 3) + j; cv[j] = __shfl(cs, src); sv[j] = __shfl(sn, src); }
        const float rk = RS[wave * 8 + rr];
#pragma unroll
        for (int hp = 0; hp < 4; ++hp) { const int head = 2 * hp + half;
            bf16_t* qp = Q + row * 1536 + head * 192 + 8 * rl;
            float v[8]; unpack8(qc[hp], v);
            if (!act) {
#pragma unroll
                for (int j = 0; j < 8; ++j) v[j] = 0.f; }
            float ssp = 0.f;
#pragma unroll
            for (int j = 0; j < 8; ++j) ssp += v[j] * v[j];
            ssp += __shfl_xor(ssp, 1); ssp += __shfl_xor(ssp, 2); ssp += __shfl_xor(ssp, 4); ssp += __shfl_xor(ssp, 8); ssp += __shfl_xor(ssp, 16);
            const float rs = rsqrtf(ssp * (1.f / 192.f) + EPS);
#pragma unroll
            for (int j = 0; j < 8; ++j) v[j] = v[j] * rs * qg[j];
#pragma unroll
            for (int j = 0; j < 8; ++j) { const float pr = __shfl_xor(v[j], 4); if (ropeA) v[j] = v[j] * cv[j] - pr * sv[j]; else if (ropeB) v[j] = v[j] * cv[j] + pr * sv[j]; }
#pragma unroll
            for (int j = 0; j < 8; ++j) v[j] *= QSCALE;
            if (act) *(u32x4*)qp = pack8(v);
        }
#pragma unroll
        for (int hp = 0; hp < 4; ++hp) { const int head = 2 * hp + half;
            bf16_t* kp = KV + row * 1536 + head * 192 + 8 * rl;
            float v[8]; unpack8(kc[hp], v);
            if (rl < 16) {
#pragma unroll
                for (int j = 0; j < 8; ++j) v[j] *= rk; }
            else if (!act) {
#pragma unroll
                for (int j = 0; j < 8; ++j) v[j] = 0.f; }
            float ssp = 0.f;
#pragma unroll
            for (int j = 0; j < 8; ++j) ssp += v[j] * v[j];
            ssp += __shfl_xor(ssp, 1); ssp += __shfl_xor(ssp, 2); ssp += __shfl_xor(ssp, 4); ssp += __shfl_xor(ssp, 8); ssp += __shfl_xor(ssp, 16);
            const float rs = rsqrtf(ssp * (1.f / 192.f) + EPS);
#pragma unroll
            for (int j = 0; j < 8; ++j) v[j] = v[j] * rs * kg[j];
#pragma unroll
            for (int j = 0; j < 8; ++j) { const float pr = __shfl_xor(v[j], 4); if (ropeA) v[j] = v[j] * cv[j] - pr * sv[j]; else if (ropeB) v[j] = v[j] * cv[j] + pr * sv[j]; }
            if (act) *(u32x4*)kp = pack8(v);
        }
        pc = pn;
#pragma unroll
        for (int hp = 0; hp < 4; ++hp) { qc[hp] = qn[hp]; kc[hp] = kn[hp]; }
    }
    __syncthreads();
}

__device__ __forceinline__ int crow(int r, int hi) { return (r & 3) + 8 * (r >> 2) + 4 * hi; }
__device__ __forceinline__ void attn_unit(LAS unsigned char* lds, int bh, int qb, const bf16_t* QN, const bf16_t* KV, const bf16_t* VT, bf16_t* AO, int lane, int wid) {
    asm volatile("" : "+v"(lane));
    const int r32 = lane & 31, hi = lane >> 5;
    const int b = bh >> 3, h = bh & 7;
    const size_t rowbase = (size_t)b * SEQ;
    const int qw0 = qb * 256 + wid * 32;
    bf16x8 qf[12];
    {
        const bf16_t* qp = QN + (rowbase + qw0 + r32) * 1536 + h * 192 + 8 * hi;
#pragma unroll
        for (int ks = 0; ks < 12; ++ks) qf[ks] = *(const bf16x8*)(qp + 16 * ks);
    }
    const float zf = opaque_zero();
    f32x16 o[4];
#pragma unroll
    for (int d = 0; d < 4; ++d)
#pragma unroll
        for (int r = 0; r < 16; ++r) o[d][r] = zf;
    float m_run = -1e30f, l_run = 0.f;
    const int NT = 4 * qb + 4;
    const bf16_t* ksrc = KV + rowbase * 1536 + h * 192;
    int koff[3];
#pragma unroll
    for (int i_ = 0; i_ < 3; ++i_) { const int idx = 64 * (wid + 8 * i_) + lane, r = idx / 24, cs = idx - 24 * r, c = (cs & ~7) | ((cs ^ (r >> 1)) & 7); koff[i_] = r * 1536 + 8 * c; }
    int okj[4];
#pragma unroll
    for (int j_ = 0; j_ < 4; ++j_) okj[j_] = r32 * 384 + ((((2 * j_ + hi) ^ (r32 >> 1)) & 7) * 16);
    const bf16_t* vsrc = VT + (rowbase + (lane >> 4)) * 1024 + h * 128 + 8 * ((lane & 15) ^ ((lane >> 4) << 2));
#define ATT_ISSUE(t_, st_) do { LAS unsigned char* Ks_ = lds + (st_) * 40960; LAS unsigned char* Vs_ = Ks_ + 24576; \
        _Pragma("unroll") for (int i_ = 0; i_ < 3; ++i_) { const int c_ = wid + 8 * i_; \
            __builtin_amdgcn_global_load_lds((const unsigned*)(ksrc + (size_t)(t_) * 64 * 1536 + koff[i_]), (LAS unsigned*)(Ks_ + c_ * 1024), 16, 0, 0); } \
        _Pragma("unroll") for (int i_ = 0; i_ < 2; ++i_) { const int p_ = wid + 8 * i_; \
            __builtin_amdgcn_global_load_lds((const unsigned*)(vsrc + (size_t)((t_) * 64 + 4 * p_) * 1024), (LAS unsigned*)(Vs_ + p_ * 1024), 16, 0, 0); } } while (0)
    const int tq = (lane & 15) >> 2, tp = lane & 3, tdg = (lane >> 4) & 1;
    ATT_ISSUE(0, 0);
    for (int t = 0; t < NT; ++t) {
        asm volatile("s_waitcnt vmcnt(0) lgkmcnt(0)\n\ts_barrier" ::: "memory");
        if (t + 1 < NT) ATT_ISSUE(t + 1, (t + 1) & 1);
        const int kv0 = 64 * t;
        if (kv0 <= qw0 + 31) {
            const LAS unsigned char* Ks = lds + (t & 1) * 40960; const LAS unsigned char* Vs = Ks + 24576;
            f32x16 p0, p1;
#pragma unroll
            for (int r = 0; r < 16; ++r) { p0[r] = zf; p1[r] = zf; }
#pragma unroll
            for (int ks = 0; ks < 12; ++ks) {
                const LAS unsigned char* kp = Ks + okj[ks & 3] + (ks >> 2) * 128;
                const bf16x8 k0 = *(const LAS bf16x8*)kp, k1 = *(const LAS bf16x8*)(kp + 12288);
                p0 = __builtin_amdgcn_mfma_f32_32x32x16_bf16(k0, qf[ks], p0, 0, 0, 0);
                p1 = __builtin_amdgcn_mfma_f32_32x32x16_bf16(k1, qf[ks], p1, 0, 0, 0);
            }
            if (kv0 + 63 > qw0) {
                const int qi = qw0 + r32;
#pragma unroll
                for (int r = 0; r < 16; ++r) { const int kvi = kv0 + crow(r, hi); if (kvi > qi) p0[r] = -1e30f; if (kvi + 32 > qi) p1[r] = -1e30f; }
            }
            float mx = fmaxf(p0[0], p1[0]);
#pragma unroll
            for (int r = 1; r < 16; ++r) mx = fmaxf(mx, fmaxf(p0[r], p1[r]));
            mx = fmaxf(mx, __shfl_xor(mx, 32));
            if (__any(mx > m_run + 8.f)) {
                const float mn = fmaxf(m_run, mx);
                const float alpha = __builtin_amdgcn_exp2f(m_run - mn);
                m_run = mn; l_run *= alpha;
#pragma unroll
                for (int d = 0; d < 4; ++d)
#pragma unroll
                    for (int r = 0; r < 16; ++r) o[d][r] *= alpha;
            }
            float sum = 0.f;
#pragma unroll
            for (int r = 0; r < 16; ++r) { p0[r] = __builtin_amdgcn_exp2f(p0[r] - m_run); p1[r] = __builtin_amdgcn_exp2f(p1[r] - m_run); sum += p0[r] + p1[r]; }
            l_run += sum;
            bf16x8 pf[4];
            {
                u32x4 w;
                w.x = cvt_pk(p0[0], p0[1]); w.y = cvt_pk(p0[2], p0[3]); w.z = cvt_pk(p0[4], p0[5]); w.w = cvt_pk(p0[6], p0[7]); pf[0] = __builtin_bit_cast(bf16x8, w);
                w.x = cvt_pk(p0[8], p0[9]); w.y = cvt_pk(p0[10], p0[11]); w.z = cvt_pk(p0[12], p0[13]); w.w = cvt_pk(p0[14], p0[15]); pf[1] = __builtin_bit_cast(bf16x8, w);
                w.x = cvt_pk(p1[0], p1[1]); w.y = cvt_pk(p1[2], p1[3]); w.z = cvt_pk(p1[4], p1[5]); w.w = cvt_pk(p1[6], p1[7]); pf[2] = __builtin_bit_cast(bf16x8, w);
                w.x = cvt_pk(p1[8], p1[9]); w.y = cvt_pk(p1[10], p1[11]); w.z = cvt_pk(p1[12], p1[13]); w.w = cvt_pk(p1[14], p1[15]); pf[3] = __builtin_bit_cast(bf16x8, w);
            }
#pragma unroll
            for (int d = 0; d < 4; ++d)
#pragma unroll
                for (int i = 0; i < 4; ++i) {
                    const LAS unsigned char* va = Vs + (16 * i + 4 * hi + tq) * 256 + (4 * (d ^ tq) + 2 * tdg + (tp >> 1)) * 16 + (tp & 1) * 8;
                    const s16x4 lo4 = __builtin_bit_cast(s16x4, __builtin_amdgcn_ds_read_tr16_b64_v4i16((LAS v4i16_t*)va));
                    const s16x4 hi4 = __builtin_bit_cast(s16x4, __builtin_amdgcn_ds_read_tr16_b64_v4i16((LAS v4i16_t*)(va + 8 * 256)));
                    const bf16x8 vf = (bf16x8){lo4[0], lo4[1], lo4[2], lo4[3], hi4[0], hi4[1], hi4[2], hi4[3]};
                    o[d] = __builtin_amdgcn_mfma_f32_32x32x16_bf16(vf, pf[i], o[d], 0, 0, 0);
                }
        }
    }
#undef ATT_ISSUE
    const float lt = l_run + __shfl_xor(l_run, 32);
    const float inv = 1.f / lt;
    bf16_t* op = AO + (rowbase + qw0 + r32) * DM + h * 128;
#pragma unroll
    for (int d = 0; d < 4; ++d)
#pragma unroll
        for (int g4 = 0; g4 < 4; ++g4) {
            u32x2 w; w.x = cvt_pk(o[d][4 * g4] * inv, o[d][4 * g4 + 1] * inv); w.y = cvt_pk(o[d][4 * g4 + 2] * inv, o[d][4 * g4 + 3] * inv);
            *(u32x2*)(op + 32 * d + 8 * g4 + 4 * hi) = w;
        }
}

#define XB_TMO      128
#define XB_XCNT(j)  (256  + 64 * (j))
#define XB_XSUB(j)  (1280 + 64 * (j))
#define XB_XGEN(j)  (2304 + 64 * (j))
#define XB_TOP      3328
#define XB_TOPGEN   3392
#define XCD_BAR_WORDS 3456
#define XB_SPIN_CAP (1u << 20)
__device__ __forceinline__ unsigned xb_ld(unsigned* p)              { return __hip_atomic_load(p, __ATOMIC_RELAXED, __HIP_MEMORY_SCOPE_AGENT); }
__device__ __forceinline__ unsigned xb_add(unsigned* p, unsigned v) { return __hip_atomic_fetch_add(p, v, __ATOMIC_RELAXED, __HIP_MEMORY_SCOPE_AGENT); }
__device__ __forceinline__ unsigned xb_xcc_id() { return (unsigned)__builtin_amdgcn_s_getreg((3 << 11) | 20) & 0xFu; }
#define XB_SPIN(cond, bar) do { unsigned _sp = 0; while (cond) { __builtin_amdgcn_s_sleep(1); \
    if ((++_sp & 255u) == 0u) { if (xb_ld(&(bar)[XB_TMO])) break; if (_sp > XB_SPIN_CAP) { atomicAdd(&(bar)[XB_TMO], 1u); break; } } } } while (0)
struct XcdBarrier { unsigned* bar; unsigned x; volatile LAS unsigned* st; };
__device__ __forceinline__ void xcd_barrier_complete(unsigned* bar, unsigned x, unsigned& nloc, unsigned& nx) {
    const unsigned G = gridDim.x * gridDim.y * gridDim.z;
    unsigned sum, cnt, mine, sp = 0u;
    for (;;) {
        sum = 0u; cnt = 0u; mine = 0u;
#pragma unroll
        for (unsigned j = 0; j < 16; ++j) { const unsigned c = xb_ld(&bar[XB_XCNT(j)]); sum += c; cnt += (c > 0u) ? 1u : 0u; mine = (j == x) ? c : mine; }
        if (sum == G) break;
        __builtin_amdgcn_s_sleep(1);
        if ((++sp & 255u) == 0u) { if (xb_ld(&bar[XB_TMO])) break; if (sp > XB_SPIN_CAP) { atomicAdd(&bar[XB_TMO], 1u); break; } }
    }
    nloc = mine > 0u ? mine : 1u; nx = cnt > 0u ? cnt : 1u;
}
__device__ __forceinline__ void xcd_barrier(const XcdBarrier& b) {
    asm volatile("s_waitcnt vmcnt(0)" ::: "memory");
    __syncthreads();
    if (threadIdx.x == 0) {
        unsigned* bar = b.bar;
        __builtin_amdgcn_s_waitcnt(0);
        unsigned nloc = b.st[0], nx = b.st[1];
        if (nloc == 0u) { xcd_barrier_complete(bar, b.x, nloc, nx); b.st[0] = nloc; b.st[1] = nx; }
        const unsigned old = xb_add(&bar[XB_XSUB(b.x)], 1u);
        const unsigned gen = old / nloc;
        if (old + 1u == (gen + 1u) * nloc) {
            __builtin_amdgcn_fence(__ATOMIC_RELEASE, "agent");
            asm volatile("s_waitcnt vmcnt(0)" ::: "memory");
            const unsigned og = xb_add(&bar[XB_TOP], 1u);
            const unsigned tg = og / nx;
            if (og + 1u == (tg + 1u) * nx) xb_add(&bar[XB_TOPGEN], 1u);
            else XB_SPIN(xb_ld(&bar[XB_TOPGEN]) == tg, bar);
            __builtin_amdgcn_fence(__ATOMIC_ACQUIRE, "agent");
            xb_add(&bar[XB_XGEN(b.x)], 1u);
            asm volatile("s_waitcnt vmcnt(0)" ::: "memory");
        } else {
            XB_SPIN(xb_ld(&bar[XB_XGEN(b.x)]) == gen, bar);
            __builtin_amdgcn_fence(__ATOMIC_ACQUIRE, "agent");
            asm volatile("s_waitcnt vmcnt(0)" ::: "memory");
        }
    }
    __syncthreads();
}

__global__ void __launch_bounds__(512, 2) mk_fwd(Args a) {
    extern __shared__ __attribute__((aligned(16))) unsigned char lds_raw[];
    cg::grid_group grid = cg::this_grid();
    const int tid0 = threadIdx.x;
    volatile LAS unsigned* xst = (volatile LAS unsigned*)((LAS unsigned char*)lds_raw + (LDS_BYTES - 64));
    if (tid0 < 16) xst[tid0] = 0u;
    __syncthreads();
    XcdBarrier xbar; xbar.bar = (unsigned*)a.ws; xbar.x = xb_xcc_id(); xbar.st = xst;
    if (MK_SINGLE && tid0 == 0) (void)xb_add(&xbar.bar[XB_XCNT(xbar.x)], 1u);
    for (int ph = a.ph_lo; ph < a.ph_hi; ++ph) {
        int tid = tid0; asm volatile("" : "+v"(tid));
        size_t zo = 0; asm volatile("" : "+s"(zo));
        int G = gridDim.x; asm volatile("" : "+s"(G));
        int bx = blockIdx.x; asm volatile("" : "+s"(bx));
        LAS unsigned char* lds = (LAS unsigned char*)lds_raw + zo;
        const int lane = tid & 63, wave = rfl(tid >> 6);
        const int vcu = (G % 8 == 0) ? (bx % 8) * (G / 8) + bx / 8 : bx;
        unsigned char* ws = a.ws + zo;
        ss_t* SS = (ss_t*)(ws + WS_SS);
        float* X = a.out + zo;
        bf16_t* XB = (bf16_t*)(ws + WS_XB);
        const float* ng = (const float*)a.in[3] + zo;
#define AIN(k) ((const float*)a.in[k] + zo)
        if (ph == 0) {
            if (EN & 512) p0_prologue(a, lds, tid, lane, wave, G, bx, zo);
        } else {
            const int i = (ph - 1) / NSUB, s = (ph - 1) % NSUB, j = i >> 1; const bool even = (i & 1) == 0;
            unsigned char* wl = ws + WS_W + (size_t)i * LW_STRIDE;
            unsigned char* we = ws + WS_WE + (size_t)j * WE_STRIDE;
            unsigned char* wo = ws + WS_WO + (size_t)j * WO_STRIDE;
            ss_t* ssb = SS + (size_t)i * 7 * M;
            if (s == 3 && even) {
                const bf16_t* Z = (const bf16_t*)(ws + WS_Z);
                if (EN & 1) for (int rep = 0; rep < 1 + PROBE_HGRN; ++rep) for (int u_ = bx; u_ < 256; u_ += G) hgrn_unit(lds, (G == 256) ? (((u_ & 7) * 4 + (u_ >> 6)) * 8 + ((u_ >> 3) & 7)) : u_, Z,     (const float*)(ws + WS_LF), (bf16_t*)(ws + WS_OH), tid, lane, wave);
                if (EN & 2) for (int u = bx; u < 2048; u += G) gmlp_unit(lds, u, Z, AIN(11) + (size_t)j * 8 * 128 * 128, AIN(12) + j * 8 * 128, AIN(10) + j * 512, (bf16_t*)(ws + WS_MIX), tid, (G & 7) != 0 || u == bx);
            } else if (s == 4 && even) {
                hgrn_onorm((const bf16_t*)(ws + WS_OH), (const bf16_t*)(ws + WS_Z), AIN(14) + j * 128, (bf16_t*)(ws + WS_MIX), lane, wave, G);
            } else if (s == 4 && !even) {
                if (EN & 4) for (int u = bx; u < 512; u += G) mla_prep_unit(lds, u, (bf16_t*)(ws + WS_Q), (bf16_t*)(ws + WS_KV), (const bf16_t*)(ws + WS_ZC), (bf16_t*)(ws + WS_VT), (const int*)AIN(2), AIN(21) + j * 192, AIN(22) + j * 192, tid, lane, wave);
            } else if (s == 5 && !even && !(EN & 8)) {
                const bf16_t* Qp = (const bf16_t*)(ws + WS_Q); const bf16_t* Kp = (const bf16_t*)(ws + WS_KV); bf16_t* Ap = (bf16_t*)(ws + WS_AO);
                for (size_t idx = (size_t)bx * 512 + tid; idx < (size_t)M * 128; idx += (size_t)G * 512) {
                    const size_t row = idx >> 7, c8 = (idx & 127) * 8;
                    float qv[8], kv[8], q2[8], k2[8], vt[8]; unpack8(*(const u32x4*)(Qp + row * 1536 + c8), qv); unpack8(*(const u32x4*)(Kp + row * 1536 + c8), kv);
                    unpack8(*(const u32x4*)(Qp + row * 1536 + 512 + c8), q2); unpack8(*(const u32x4*)(Kp + row * 1536 + 512 + c8), k2);
                    unpack8(*(const u32x4*)((const bf16_t*)(ws + WS_VT) + row * 1024 + c8), vt);
#pragma unroll
                    for (int e = 0; e < 8; ++e) qv[e] = 0.5f * (STQ * (qv[e] + q2[e]) + STK * (kv[e] + k2[e]) + STV * vt[e]);
                    *(u32x4*)(Ap + row * 1024 + c8) = pack8(qv);
                }
            } else if (s == 5 && !even) {
                if (EN & 8) for (int rep = 0; rep < 1 + PROBE_ATT; ++rep) for (int v = vcu; v < 256; v += G) {
                    const int bh = v >> 2, sx = v & 3;
#pragma unroll 1
                    for (int k = 0; k < 4; ++k) { const int qb = (k == 0) ? 15 - sx : (k == 1) ? 8 + sx : (k == 2) ? 7 - sx : sx;
                        attn_unit(lds, bh, qb, (const bf16_t*)(ws + WS_Q), (const bf16_t*)(ws + WS_KV), (const bf16_t*)(ws + WS_VT), (bf16_t*)(ws + WS_AO), lane, wave); }
                }
                __syncthreads();
            } else if (s == 7) {
                p_convert(AIN(1) + (size_t)i * M * 256, (bf16_t*)(ws + WS_PB), tid, G);
            } else if (s == 10) {
                ple_finalize(i == DEPTH - 1 ? X : (float*)nullptr, (const bf16_t*)(ws + WS_TBUF), ssb + 4 * M, ng + (i * 5 + 4) * 1024, XB, SS + (size_t)(i + 1) * 7 * M, lane, wave, G);
            }
            __syncthreads();
            if (s == 0 || s == 7) {
                pg8::EpiUp E{(bf16_t*)(ws + WS_ACT), ssb + (s ? 2 : 0) * M};
                if (EN & 16) pg8::gemm_phase<2 * DFF, DM, DM, DM>(lds, XB, (const bf16_t*)(wl + (s ? OFF_WUP1 : OFF_WUP0)), G, tid, E);
            } else if (s == 1 || s == 8) {
                pg8::EpiResid E{XB, ssb + (s == 8 ? 3 : 1) * M, 0.5f};
                if (EN & 32) pg8::gemm_phase<DM, DFF, DFF, DFF>(lds, (const bf16_t*)(ws + WS_ACT), (const bf16_t*)(wl + (s == 8 ? OFF_WDN1 : OFF_WDN0)), G, tid, E);
                if (s == 8) {
                    __syncthreads();
                    pg8::EpiScale E2{(bf16_t*)(ws + WS_PBUF), DM, nullptr, 0.f, nullptr, nullptr, 0};
                    if (EN & 64) pg8::gemm_phase<DM, 256, 256, 256>(lds, (const bf16_t*)(ws + WS_PB), (const bf16_t*)(wl + OFF_WPP), G, tid, E2);
                }
            } else if (s == 2 && even) {
                pg8::EpiEvenIn E{(bf16_t*)(ws + WS_Z), (float*)(ws + WS_LF), ssb + 1 * M, (const float*)(ws + WS_LB) + j * 512};
                if (EN & 128) pg8::gemm_phase<3072, DM, DM, DM>(lds, XB, (const bf16_t*)(we + OFF_WEIN), G, tid, E);
            } else if (s == 2) {
                pg8::EpiScale E{(bf16_t*)(ws + WS_ZC), 768, ssb + 1 * M, 1.f / 1024.f, nullptr, nullptr, 0};
                if (EN & 64) pg8::gemm_phase<768, DM, DM, DM>(lds, XB, (const bf16_t*)(wo + OFF_WMIN), G, tid, E);
            } else if (s == 3 && !even) {
                pg8::EpiScale E{(bf16_t*)(ws + WS_Q), 1536, nullptr, 0.f, nullptr, nullptr, 0};
                if (EN & 64) pg8::gemm_phase<1536, 384, 768, 384>(lds, (const bf16_t*)(ws + WS_ZC), (const bf16_t*)(wo + OFF_WQB), G, tid, E);
                __syncthreads();
                pg8::EpiKV E2{(bf16_t*)(ws + WS_KV), (bf16_t*)(ws + WS_VT), ssb + 6 * M};
                if (EN & 64) pg8::gemm_phase<2048, 256, 768, 256>(lds, (const bf16_t*)(ws + WS_ZC) + 384, (const bf16_t*)(wo + OFF_WKVB), G, tid, E2);
            } else if (s == 6) {
                pg8::EpiResid E{XB, ssb + 2 * M, 1.0f};
                if (EN & 32) pg8::gemm_phase<DM, DM, DM, DM>(lds, (const bf16_t*)(ws + (even ? WS_MIX : WS_AO)), (const bf16_t*)(even ? we + OFF_WEOUT : wo + OFF_WMOUT), G, tid, E);
            } else if (s == 9) {
                pg8::EpiPleG E{(const bf16_t*)(ws + WS_PBUF), (bf16_t*)(ws + WS_TBUF), ssb + 3 * M, ssb + 4 * M};
                if (EN & 256) pg8::gemm_phase<DM, DM, DM, DM>(lds, XB, (const bf16_t*)(wl + OFF_WPG), G, tid, E);
            }
        }
        if (ph + 1 < a.ph_hi) {
            if (ph >= 1 && ((ph - 1) % NSUB) == 5 && ((((ph - 1) / NSUB) & 1) == 0)) continue;
            if (ph == 0) grid.sync(); else xcd_barrier(xbar);
            if (PROBE_SYNC) xcd_barrier(xbar);
        }
    }
}

extern "C" void kernel_launch(void* const* d_in, const int* in_sizes, int n_in, void* d_out, int out_size, void* d_ws, size_t ws_size, hipStream_t stream) {
    static int grid = 0;
    if (grid == 0) {
        if (n_in != 24 || out_size != M * DM || ws_size < WS_END) { fprintf(stderr, "kernel_launch: unexpected problem (n_in %d out %d ws %zu)\n", n_in, out_size, ws_size); grid = -1; return; }
        int dev = 0, cus = 0, per_cu = 0;
        hipGetDevice(&dev); hipDeviceGetAttribute(&cus, hipDeviceAttributeMultiprocessorCount, dev);
        hipFuncSetAttribute((const void*)mk_fwd, hipFuncAttributeMaxDynamicSharedMemorySize, LDS_BYTES);
        if (hipOccupancyMaxActiveBlocksPerMultiprocessor(&per_cu, (const void*)mk_fwd, 512, LDS_BYTES) != hipSuccess || per_cu < 1) { fprintf(stderr, "kernel_launch: occupancy query says %d\n", per_cu); per_cu = 1; }
        (void)hipGetLastError();
        grid = cus;
    }
    if (grid < 0) return;
    Args a{};
    for (int i = 0; i < 24; ++i) a.in[i] = d_in[i];
    a.out = (float*)d_out; a.ws = (unsigned char*)d_ws;
#if MK_SINGLE
    (void)hipMemsetAsync(d_ws, 0, 16384, stream);
    a.ph_lo = 0; a.ph_hi = NPH;
    void* args[] = {&a};
    hipError_t e = hipLaunchCooperativeKernel((const void*)mk_fwd, dim3(grid), dim3(512), args, LDS_BYTES, stream);
    if (e != hipSuccess) fprintf(stderr, "cooperative launch failed: %s (grid %d)\n", hipGetErrorString(e), grid);
#else
    for (int ph = 0; ph < NPH; ++ph) {
        a.ph_lo = ph; a.ph_hi = ph + 1;
        hipLaunchKernelGGL(mk_fwd, dim3(grid), dim3(512), LDS_BYTES, stream, a);
    }
#endif
}
```

```cpp
#include <hip/hip_runtime.h>
#include <hip/hip_cooperative_groups.h>
#include <cstdio>
#include <cstdint>
namespace cg = cooperative_groups;

#ifndef MK_SINGLE
#define MK_SINGLE 1
#endif
#ifndef EN
#define EN 0xffff
#ifndef PROBE_SYNC
#define PROBE_SYNC 0
#endif
#ifndef PROBE_HGRN
#define PROBE_HGRN 0
#endif
#ifndef PROBE_ATT
#define PROBE_ATT 0
#endif
#define VTEST 0
#define STQ 0.f
#define STK 0.f
#define STV 1.f
#endif

#define LAS __attribute__((address_space(3)))
typedef unsigned short bf16_t;
typedef short bf16x8 __attribute__((ext_vector_type(8)));
typedef float f32x4 __attribute__((ext_vector_type(4)));
typedef float f32x16 __attribute__((ext_vector_type(16)));
typedef unsigned u32x4 __attribute__((ext_vector_type(4)));
typedef unsigned u32x2 __attribute__((ext_vector_type(2)));
typedef short s16x4 __attribute__((ext_vector_type(4)));
typedef short v4i16_t __attribute__((ext_vector_type(4)));

constexpr int M = 32768, DM = 1024, SEQ = 4096, DFF = 2816, DEPTH = 4;
constexpr float EPS = 1e-6f;
constexpr int NSUB = 11, NPH = 1 + DEPTH * NSUB;

constexpr size_t MiB = 1u << 20;
constexpr size_t WS_SS = 576 * MiB;
constexpr size_t WS_LB = 3840 * 1024;
constexpr size_t WS_W = 4 * MiB;
constexpr size_t LW_STRIDE = 36 * MiB;
constexpr size_t OFF_WUP0 = 0, OFF_WUP1 = 11 * MiB, OFF_WDN0 = 22 * MiB, OFF_WDN1 = 22 * MiB + 5632 * 1024, OFF_WPG = 33 * MiB, OFF_WPP = 35 * MiB;
constexpr size_t WS_WE = 148 * MiB, WE_STRIDE = 8 * MiB, OFF_WEIN = 0, OFF_WEOUT = 6 * MiB;
constexpr size_t WS_WO = 164 * MiB, WO_STRIDE = 6 * MiB, OFF_WMIN = 0, OFF_WQB = 1536 * 1024, OFF_WKVB = 2816 * 1024, OFF_WMOUT = 3840 * 1024;
constexpr size_t WS_XB = 176 * MiB;
constexpr size_t WS_PB = 240 * MiB;
constexpr size_t WS_BIG = 256 * MiB;
constexpr size_t WS_ACT = WS_BIG;
constexpr size_t WS_PBUF = 432 * MiB;
constexpr size_t WS_TBUF = WS_BIG;
constexpr size_t WS_Z = WS_BIG;
constexpr size_t WS_LF = 416 * MiB;
constexpr size_t WS_MIX = 480 * MiB;
constexpr size_t WS_AO = WS_BIG;
constexpr size_t WS_ZC = WS_BIG;
constexpr size_t WS_Q = 320 * MiB;
constexpr size_t WS_KV = 416 * MiB;
constexpr size_t WS_OH = 544 * MiB;
constexpr size_t WS_VT = 512 * MiB;
constexpr size_t WS_END = 584 * MiB;

constexpr int LDS_BYTES = 147456;

typedef float f32x2_t __attribute__((ext_vector_type(2)));
typedef __bf16 bf16x2_t __attribute__((ext_vector_type(2)));
__device__ __forceinline__ unsigned cvt_pk(float lo, float hi) { f32x2_t v = {lo, hi}; bf16x2_t b = __builtin_convertvector(v, bf16x2_t); return __builtin_bit_cast(unsigned, b); }
__device__ __forceinline__ float bf_lo(unsigned w) { return __uint_as_float(w << 16); }
__device__ __forceinline__ float bf_hi(unsigned w) { return __uint_as_float(w & 0xffff0000u); }
__device__ __forceinline__ void unpack8(const u32x4 w, float* f) { f[0] = bf_lo(w.x); f[1] = bf_hi(w.x); f[2] = bf_lo(w.y); f[3] = bf_hi(w.y); f[4] = bf_lo(w.z); f[5] = bf_hi(w.z); f[6] = bf_lo(w.w); f[7] = bf_hi(w.w); }
__device__ __forceinline__ u32x4 pack8(const float* f) { u32x4 w; w.x = cvt_pk(f[0], f[1]); w.y = cvt_pk(f[2], f[3]); w.z = cvt_pk(f[4], f[5]); w.w = cvt_pk(f[6], f[7]); return w; }
__device__ __forceinline__ float fast_rcp(float x) { return __builtin_amdgcn_rcpf(x); }
__device__ __forceinline__ float sigmoidf_(float x) { return fast_rcp(1.f + __expf(-x)); }
__device__ __forceinline__ float siluf_(float x) { return x * sigmoidf_(x); }
__device__ __forceinline__ float gelu_tanh(float v) { const float t = 1.5957691216057308f * (v + 0.044715f * v * v * v); return v * sigmoidf_(t); }
__device__ __forceinline__ float wave_sum(float v) {
#pragma unroll
    for (int o = 1; o < 64; o <<= 1) v += __shfl_xor(v, o);
    return v;
}
__device__ __forceinline__ int rfl(int v) { return __builtin_amdgcn_readfirstlane(v); }
typedef unsigned long long ss_t;
__device__ __forceinline__ float ss_load(const ss_t* p, size_t row) { return (float)(long long)p[row] * (1.f / 1048576.f); }
__device__ __forceinline__ ss_t ss_fix(float v) { return (ss_t)(long long)__float2ll_rn(v * 1048576.f); }
__device__ __forceinline__ void ss_add(ss_t* p, size_t row, float v) { atomicAdd(p + row, ss_fix(v)); }
__device__ __forceinline__ float opaque_zero() { float z = 0.f; asm volatile("" : "+v"(z)); return z; }
__device__ __forceinline__ unsigned opaque_zero_u() { unsigned z = 0u; asm volatile("" : "+v"(z)); return z; }

namespace pg8 {
constexpr int BM = 256, BK = 64, HALF = 128, HTB = HALF * BK * 2, STAGE_BYTES = 8 * HTB, NXCD = 8, WGM = 8;
__host__ __device__ __forceinline__ int lds_byte(int r, int c) { const int st = (r >> 4) * 2 + (c >> 5), rr = r & 15, cc = c & 31, ob = rr * 64 + cc * 2; return st * 1024 + (ob ^ (((ob >> 9) & 1) << 5)); }
__host__ __device__ __forceinline__ void stage_rc(int b, int& R, int& C) { const int st = b / 1024, sb = b % 1024, swz = sb ^ (((sb >> 9) & 1) << 5); R = (st >> 1) * 16 + swz / 64; C = (st & 1) * 32 + (swz % 64) / 2; }
__host__ __device__ __forceinline__ int perm32(int rho) { const int n = rho >> 4, i = rho & 15; return 8 * (i >> 2) + 4 * n + (i & 3); }

struct Unit { int pm, pn; };
struct Gemm { const bf16_t* A; const bf16_t* Bt; int lda, ldb, M, N, K; };

struct StaticOrder {
    int nM, nN, nwg, G, c;
    __device__ void init(int M_, int N_, int G_, int c_) { nM = M_ / BM; nN = N_ / BM; nwg = nM * nN; G = G_; c = c_; }
    __device__ bool next(int i, Unit& u) const {
        const long L = (long)i * G + c; if (L >= nwg) return false;
        int wgid = (int)L; { const int q = nwg / NXCD, r = nwg % NXCD, xcd = wgid % NXCD, off = wgid / NXCD; wgid = (xcd < r ? xcd * (q + 1) : r * (q + 1) + (xcd - r) * q) + off; }
        const int nig = WGM * nN, gid = wgid / nig, fm = gid * WGM, gsz = (nM - fm) < WGM ? (nM - fm) : WGM;
        u.pm = fm + ((wgid % nig) % gsz); u.pn = (wgid % nig) / gsz; return true;
    }
};

template <int N_, int K_, int LDA, int LDB, class Epi>
__device__ __forceinline__ void gemm_phase(LAS unsigned char* lds, const bf16_t* gA, const bf16_t* gBt, int G, int tid, const Epi& E) {
    asm volatile("" : "+v"(tid));
    StaticOrder S; S.init(32768, N_, G, (int)blockIdx.x);
    const int wid = __builtin_amdgcn_readfirstlane(tid >> 6), lane = tid & 63, wr = wid >> 2, wc = wid & 3, fr = lane & 15, fq = lane >> 4;
    constexpr int K = K_, nt = K / BK;
    struct { const bf16_t* A; const bf16_t* Bt; int lda, ldb; } g{gA, gBt, LDA, LDB};
    unsigned voffA[2], voffB[2];
#pragma unroll
    for (int i = 0; i < 2; ++i) { int R, C; stage_rc(tid * 16 + i * 8192, R, C); const int Rb = (R & ~31) + perm32(R & 31);
        voffA[i] = (unsigned)(R * g.lda + C) * 2u; voffB[i] = (unsigned)(Rb * g.ldb + C) * 2u; }
    const size_t kstep = (size_t)(BK * 2);
    const size_t hstepA = (size_t)HALF * g.lda * 2, hstepB = (size_t)HALF * g.ldb * 2;
    const size_t tstepA = 2 * hstepA, tstepB = 2 * hstepB;
    const unsigned ldsw = (unsigned)wid * 1024u;
    const int aoff = lds_byte(wr * 64 + fr, fq * 8), boff = lds_byte(wc * 32 + fr, fq * 8);
#define PG8_SA(b, h) (((b) * 2 + (h)) * HTB)
#define PG8_SB(b, h) ((4 + (b) * 2 + (h)) * HTB)
#define PG8_STAGE(bufoff, gbase, voff) do { _Pragma("unroll") for (int _i = 0; _i < 2; ++_i) \
        __builtin_amdgcn_global_load_lds((const unsigned*)((const char*)(gbase) + (voff)[_i]), (LAS unsigned*)(lds + (bufoff) + ldsw + _i * 8192), 16, 0, 0); } while (0)
#define PG8_LDA(dst, b, h) do { _Pragma("unroll") for (int m = 0; m < 4; ++m) _Pragma("unroll") for (int k = 0; k < 2; ++k) dst[m][k] = *(const LAS bf16x8*)(lds + PG8_SA(b, h) + aoff + m * 2048 + k * 1024); } while (0)
#define PG8_LDB(dst, b, h) do { _Pragma("unroll") for (int n = 0; n < 2; ++n) _Pragma("unroll") for (int k = 0; k < 2; ++k) dst[n][k] = *(const LAS bf16x8*)(lds + PG8_SB(b, h) + boff + n * 2048 + k * 1024); } while (0)
#define PG8_MMA(ai, bj, At, Bt) do { __builtin_amdgcn_s_setprio(1); _Pragma("unroll") for (int m = 0; m < 4; ++m) _Pragma("unroll") for (int n = 0; n < 2; ++n) _Pragma("unroll") for (int k = 0; k < 2; ++k) \
        acc[ai][bj][m][n] = __builtin_amdgcn_mfma_f32_16x16x32_bf16(Bt[n][k], At[m][k], acc[ai][bj][m][n], 0, 0, 0); __builtin_amdgcn_s_setprio(0); } while (0)
#define PG8_WAIT_V(n) asm volatile("s_waitcnt vmcnt(" #n ")" ::: "memory")
#define PG8_WAIT_L(n) asm volatile("s_waitcnt lgkmcnt(" #n ")" ::: "memory")
#define PG8_BAR __builtin_amdgcn_s_barrier()
#define PG8_SCHED __builtin_amdgcn_sched_barrier(0)
    Unit cur, nxt; int ui = 0;
    if (!S.next(0, cur)) return;
    const float zf = opaque_zero();
    f32x4 acc[2][2][4][2];
#pragma unroll
    for (int a = 0; a < 2; ++a)
#pragma unroll
        for (int b = 0; b < 2; ++b)
#pragma unroll
            for (int m = 0; m < 4; ++m)
#pragma unroll
                for (int n = 0; n < 2; ++n) acc[a][b][m][n] = (f32x4){zf, zf, zf, zf};
    bf16x8 At[4][2], B0[2][2], B1[2][2];
    typename Epi::Pre pre;
    const char* cA = (const char*)g.A + (size_t)cur.pm * tstepA; const char* cB = (const char*)g.Bt + (size_t)cur.pn * tstepB;
    PG8_STAGE(PG8_SB(0, 0), cB, voffB); PG8_STAGE(PG8_SB(0, 1), cB + hstepB, voffB); PG8_STAGE(PG8_SA(0, 0), cA, voffA); PG8_STAGE(PG8_SA(0, 1), cA + hstepA, voffA);
    if (wr == 1) PG8_BAR;
    PG8_WAIT_V(2); PG8_BAR;
    PG8_STAGE(PG8_SB(1, 0), cB + kstep, voffB); PG8_STAGE(PG8_SA(1, 0), cA + kstep, voffA); PG8_STAGE(PG8_SB(1, 1), cB + hstepB + kstep, voffB);
    PG8_WAIT_V(6); PG8_BAR;
    for (;;) {
        const bool has_next = S.next(ui + 1, nxt);
        const char* nA = has_next ? (const char*)g.A + (size_t)nxt.pm * tstepA : cA; const char* nB = has_next ? (const char*)g.Bt + (size_t)nxt.pn * tstepB : cB;
#pragma unroll 1
        for (int t = 0; t < nt; t += 2) {
            const bool last = (t == nt - 2);
            const char* a1 = cA + (size_t)(t + 1) * kstep;
            const char* a2 = last ? nA : cA + (size_t)(t + 2) * kstep; const char* b2 = last ? nB : cB + (size_t)(t + 2) * kstep;
            const char* a3 = a2 + kstep; const char* b3 = b2 + kstep;
            if (last) E.prefetch(pre, cur, wr, wc, fr, fq);
            PG8_LDB(B0, 0, 0); PG8_LDB(B1, 0, 1); PG8_SCHED; PG8_LDA(At, 0, 0); PG8_STAGE(PG8_SA(1, 1), a1 + hstepA, voffA);
            PG8_WAIT_V(8); PG8_WAIT_L(0); PG8_BAR; PG8_MMA(0, 0, At, B0); PG8_MMA(0, 1, At, B1); PG8_BAR; PG8_SCHED;
            PG8_LDA(At, 0, 1); PG8_STAGE(PG8_SB(0, 0), b2, voffB); PG8_STAGE(PG8_SB(0, 1), b2 + hstepB, voffB); PG8_STAGE(PG8_SA(0, 0), a2, voffA);
            PG8_WAIT_V(8); PG8_WAIT_L(0); PG8_BAR; PG8_MMA(1, 0, At, B0); PG8_MMA(1, 1, At, B1); PG8_BAR; PG8_SCHED;
            PG8_LDB(B0, 1, 0); PG8_LDB(B1, 1, 1); PG8_SCHED; PG8_LDA(At, 1, 0); PG8_STAGE(PG8_SA(0, 1), a2 + hstepA, voffA);
            PG8_WAIT_V(8); PG8_WAIT_L(0); PG8_BAR; PG8_MMA(0, 0, At, B0); PG8_MMA(0, 1, At, B1); PG8_BAR; PG8_SCHED;
            PG8_LDA(At, 1, 1); PG8_STAGE(PG8_SB(1, 0), b3, voffB); PG8_STAGE(PG8_SB(1, 1), b3 + hstepB, voffB); PG8_STAGE(PG8_SA(1, 0), a3, voffA);
            PG8_WAIT_V(8); PG8_WAIT_L(0); PG8_BAR; PG8_MMA(1, 0, At, B0); PG8_MMA(1, 1, At, B1); PG8_BAR; PG8_SCHED;
        }
        if (wr == 0) PG8_BAR;
        E(acc, cur, wr, wc, fr, fq, pre);
        if (!has_next) break;
#pragma unroll
        for (int a = 0; a < 2; ++a)
#pragma unroll
            for (int b = 0; b < 2; ++b)
#pragma unroll
                for (int m = 0; m < 4; ++m)
#pragma unroll
                    for (int n = 0; n < 2; ++n) acc[a][b][m][n] = (f32x4){zf, zf, zf, zf};
        cur = nxt; cA = nA; cB = nB; ++ui;
        if (wr == 1) PG8_BAR;
    }
    PG8_WAIT_V(0);
    PG8_BAR;
#undef PG8_SA
#undef PG8_SB
#undef PG8_STAGE
#undef PG8_LDA
#undef PG8_LDB
#undef PG8_MMA
#undef PG8_WAIT_V
#undef PG8_WAIT_L
#undef PG8_BAR
#undef PG8_SCHED
}

typedef f32x4 AccT[2][2][4][2];

struct EpiUp {
    bf16_t* O; const ss_t* ss;
    struct Pre { ss_t sv[4]; };
    __device__ __forceinline__ void prefetch(Pre& p, const Unit& u, int wr, int wc, int fr, int fq) const {
        const int row0 = u.pm * BM + wr * 64 + fr;
#pragma unroll
        for (int gi = 0; gi < 4; ++gi) p.sv[gi] = ss[row0 + (gi >> 2) * HALF + (gi & 3) * 16];
    }
    __device__ __forceinline__ void operator()(const AccT& acc, const Unit& u, int wr, int wc, int fr, int fq, const Pre& p) const {
        const int row0 = u.pm * BM + wr * 64 + fr, col0 = u.pn * 128 + wc * 32 + 8 * fq;
        ss_t sv[8];
#pragma unroll
        for (int gi = 0; gi < 4; ++gi) { sv[gi] = p.sv[gi]; sv[4 + gi] = ss[row0 + HALF + gi * 16]; }
#pragma unroll
        for (int gi = 0; gi < 8; ++gi) {
            const int ai = gi >> 2, m = gi & 3;
            const int row = row0 + ai * HALF + m * 16;
            const float rs = rsqrtf((float)(long long)sv[gi] * (1.f / 1048576.f) * (1.f / 1024.f) + EPS);
            float o[8];
#pragma unroll
            for (int n = 0; n < 2; ++n)
#pragma unroll
                for (int e = 0; e < 4; ++e) { const float gv = acc[ai][0][m][n][e] * rs, uv = acc[ai][1][m][n][e] * rs; o[4 * n + e] = siluf_(gv) * uv; }
            *(u32x4*)(O + (size_t)row * DFF + col0) = pack8(o);
        }
    }
};
struct EpiResid {
    bf16_t* xb; ss_t* ss_out; float alpha;
    struct Pre { u32x4 c[2]; };
    __device__ __forceinline__ void prefetch(Pre& p, const Unit& u, int wr, int wc, int fr, int fq) const {
        const int row0 = u.pm * BM + wr * 64 + fr, col0 = u.pn * BM + wc * 32 + 8 * fq;
#pragma unroll
        for (int bj = 0; bj < 2; ++bj) p.c[bj] = *(const u32x4*)(xb + (size_t)row0 * DM + col0 + bj * HALF);
    }
    __device__ __forceinline__ void operator()(const AccT& acc, const Unit& u, int wr, int wc, int fr, int fq, const Pre& p) const {
        const int row0 = u.pm * BM + wr * 64 + fr, col0 = u.pn * BM + wc * 32 + 8 * fq;
        u32x4 cur[2], nxt[2];
        cur[0] = p.c[0]; cur[1] = p.c[1];
#pragma unroll
        for (int gi = 0; gi < 8; ++gi) {
            const int ai = gi >> 2, m = gi & 3;
            const int row = row0 + ai * HALF + m * 16; float ssp = 0.f;
            if (gi + 1 < 8) { const int rown = row0 + ((gi + 1) >> 2) * HALF + ((gi + 1) & 3) * 16;
#pragma unroll
                for (int bj = 0; bj < 2; ++bj) nxt[bj] = *(const u32x4*)(xb + (size_t)rown * DM + col0 + bj * HALF); }
#pragma unroll
            for (int bj = 0; bj < 2; ++bj) {
                const size_t off = (size_t)row * DM + col0 + bj * HALF;
                float b[8]; unpack8(cur[bj], b);
                float v[8];
#pragma unroll
                for (int e = 0; e < 4; ++e) { v[e] = b[e] + acc[ai][bj][m][0][e] * alpha; v[4 + e] = b[4 + e] + acc[ai][bj][m][1][e] * alpha; }
                *(u32x4*)(xb + off) = pack8(v);
#pragma unroll
                for (int e = 0; e < 8; ++e) ssp += v[e] * v[e];
            }
            ssp += __shfl_xor(ssp, 16); ssp += __shfl_xor(ssp, 32);
            if (fq == 0) ss_add(ss_out, row, ssp);
            cur[0] = nxt[0]; cur[1] = nxt[1];
        }
    }
};
struct EpiScale {
    bf16_t* O; int ldc; const ss_t* ss_in; float inv_n; ss_t* ss_o0; ss_t* ss_o1; int sscode;
    struct Pre { int dummy; };
    __device__ __forceinline__ void prefetch(Pre&, const Unit&, int, int, int, int) const {}
    __device__ __forceinline__ void operator()(const AccT& acc, const Unit& u, int wr, int wc, int fr, int fq, const Pre&) const {
        const int row0 = u.pm * BM + wr * 64 + fr, col0 = u.pn * BM + wc * 32 + 8 * fq;
        ss_t sv[8];
#pragma unroll
        for (int gi = 0; gi < 8; ++gi) sv[gi] = ss_in ? ss_in[row0 + (gi >> 2) * HALF + (gi & 3) * 16] : (ss_t)0;
#pragma unroll
        for (int ai = 0; ai < 2; ++ai)
#pragma unroll
            for (int m = 0; m < 4; ++m) {
                const int row = row0 + ai * HALF + m * 16;
                const float rs = ss_in ? rsqrtf((float)(long long)sv[ai * 4 + m] * (1.f / 1048576.f) * inv_n + EPS) : 1.f;
#pragma unroll
                for (int bj = 0; bj < 2; ++bj) {
                    const f32x4 v0 = acc[ai][bj][m][0] * rs, v1 = acc[ai][bj][m][1] * rs;
                    u32x4 w; w.x = cvt_pk(v0[0], v0[1]); w.y = cvt_pk(v0[2], v0[3]); w.z = cvt_pk(v1[0], v1[1]); w.w = cvt_pk(v1[2], v1[3]);
                    *(u32x4*)(O + (size_t)row * ldc + col0 + bj * HALF) = w;
                    const int code = (sscode >> (2 * (u.pn * 2 + bj))) & 3;
                    if (code) {
                        float ssp = (v0[0] * v0[0] + v0[1] * v0[1]) + (v0[2] * v0[2] + v0[3] * v0[3]) + (v1[0] * v1[0] + v1[1] * v1[1]) + (v1[2] * v1[2] + v1[3] * v1[3]);
                        ssp += __shfl_xor(ssp, 16); ssp += __shfl_xor(ssp, 32);
                        if (fq == 0) ss_add(code == 1 ? ss_o0 : ss_o1, row, ssp);
                    }
                }
            }
    }
};
struct EpiKV {
    bf16_t* KB; bf16_t* VT; const ss_t* ss_in;
    struct Pre { int dummy; };
    __device__ __forceinline__ void prefetch(Pre&, const Unit&, int, int, int, int) const {}
    __device__ __forceinline__ void operator()(const AccT& acc, const Unit& u, int wr, int wc, int fr, int fq, const Pre&) const {
        const int row0 = u.pm * BM + wr * 64 + fr, c0 = wc * 32 + 8 * fq;
#pragma unroll
        for (int ai = 0; ai < 2; ++ai)
#pragma unroll
            for (int m = 0; m < 4; ++m) {
                const int row = row0 + ai * HALF + m * 16;
                {
                    const f32x4 v0 = acc[ai][0][m][0], v1 = acc[ai][0][m][1];
                    u32x4 w; w.x = cvt_pk(v0[0], v0[1]); w.y = cvt_pk(v0[2], v0[3]); w.z = cvt_pk(v1[0], v1[1]); w.w = cvt_pk(v1[2], v1[3]);
                    *(u32x4*)(KB + (size_t)row * 1536 + u.pn * 192 + c0) = w;
                }
                {
                    const f32x4 v0 = acc[ai][1][m][0], v1 = acc[ai][1][m][1];
                    const unsigned w[4] = {cvt_pk(v0[0], v0[1]), cvt_pk(v0[2], v0[3]), cvt_pk(v1[0], v1[1]), cvt_pk(v1[2], v1[3])};
                    { u32x4 ww; ww.x = w[0]; ww.y = w[1]; ww.z = w[2]; ww.w = w[3]; *(u32x4*)(VT + (size_t)row * 1024 + u.pn * 128 + c0) = ww; }
                }
            }
    }
};
struct EpiEvenIn {
    bf16_t* Z; float* LF; const ss_t* ss; const float* lb;
    struct Pre { ss_t sv[4]; };
    __device__ __forceinline__ void prefetch(Pre& p, const Unit& u, int wr, int wc, int fr, int fq) const {
        const int row0 = u.pm * BM + wr * 64 + fr;
#pragma unroll
        for (int gi = 0; gi < 4; ++gi) p.sv[gi] = ss[row0 + (gi >> 2) * HALF + (gi & 3) * 16];
    }
    __device__ __forceinline__ void operator()(const AccT& acc, const Unit& u, int wr, int wc, int fr, int fq, const Pre& p) const {
        const int row0 = u.pm * BM + wr * 64 + fr, col0 = u.pn * BM + wc * 32 + 8 * fq;
        const int kind = u.pn >> 1;
        ss_t sv[8];
#pragma unroll
        for (int gi = 0; gi < 4; ++gi) { sv[gi] = p.sv[gi]; sv[4 + gi] = ss[row0 + HALF + gi * 16]; }
#pragma unroll
        for (int ai = 0; ai < 2; ++ai)
#pragma unroll
            for (int m = 0; m < 4; ++m) {
                const int row = row0 + ai * HALF + m * 16;
                const float rs = rsqrtf((float)(long long)sv[ai * 4 + m] * (1.f / 1048576.f) * (1.f / 1024.f) + EPS);
#pragma unroll
                for (int bj = 0; bj < 2; ++bj) {
                    const int col = col0 + bj * HALF;
                    float v[8];
#pragma unroll
                    for (int e = 0; e < 4; ++e) { v[e] = acc[ai][bj][m][0][e] * rs; v[4 + e] = acc[ai][bj][m][1][e] * rs; }
                    if (kind == 3) {
                        const int cf = col - 1536;
                        f32x4 l0, l1;
#pragma unroll
                        for (int e = 0; e < 8; ++e) { const float lbv = lb[cf + e]; const float f = lbv + (1.f - lbv) * sigmoidf_(v[e]); const float lf = __logf(fmaxf(f, 1e-6f)); if (e < 4) l0[e] = lf; else l1[e - 4] = lf; }
                        *(f32x4*)(LF + (size_t)row * 512 + cf) = l0; *(f32x4*)(LF + (size_t)row * 512 + cf + 4) = l1;
                    } else {
                        if (kind <= 1) {
#pragma unroll
                            for (int e = 0; e < 8; ++e) v[e] = gelu_tanh(v[e]);
                        } else if (kind == 5) {
#pragma unroll
                            for (int e = 0; e < 8; ++e) v[e] = siluf_(v[e]);
                        }
                        const int dc = kind >= 4 ? col - 512 : col;
                        *(u32x4*)(Z + (size_t)row * 2560 + dc) = pack8(v);
                    }
                }
            }
    }
};
struct EpiPleG {
    const bf16_t* P; bf16_t* T; const ss_t* ss; ss_t* tss;
    struct Pre { ss_t sv[4]; };
    __device__ __forceinline__ void prefetch(Pre& p, const Unit& u, int wr, int wc, int fr, int fq) const {
        const int row0 = u.pm * BM + wr * 64 + fr, col0 = u.pn * BM + wc * 32 + 8 * fq;
#pragma unroll
        for (int gi = 0; gi < 4; ++gi) p.sv[gi] = ss[row0 + (gi >> 2) * HALF + (gi & 3) * 16];
    }
    __device__ __forceinline__ void operator()(const AccT& acc, const Unit& u, int wr, int wc, int fr, int fq, const Pre& p) const {
        const int row0 = u.pm * BM + wr * 64 + fr, col0 = u.pn * BM + wc * 32 + 8 * fq;
        ss_t sv[8];
#pragma unroll
        for (int gi = 0; gi < 4; ++gi) { sv[gi] = p.sv[gi]; sv[4 + gi] = ss[row0 + HALF + gi * 16]; }
        u32x4 cur[2], nxt[2];
#pragma unroll
        for (int bj = 0; bj < 2; ++bj) cur[bj] = *(const u32x4*)(P + (size_t)row0 * DM + col0 + bj * HALF);
#pragma unroll
        for (int gi = 0; gi < 8; ++gi) {
            const int ai = gi >> 2, m = gi & 3;
            const int row = row0 + ai * HALF + m * 16; float ssp = 0.f;
            if (gi + 1 < 8) { const int rown = row0 + ((gi + 1) >> 2) * HALF + ((gi + 1) & 3) * 16;
#pragma unroll
                for (int bj = 0; bj < 2; ++bj) nxt[bj] = *(const u32x4*)(P + (size_t)rown * DM + col0 + bj * HALF); }
            const float rs = rsqrtf((float)(long long)sv[gi] * (1.f / 1048576.f) * (1.f / 1024.f) + EPS);
#pragma unroll
            for (int bj = 0; bj < 2; ++bj) {
                const size_t off = (size_t)row * DM + col0 + bj * HALF;
                float pv[8]; unpack8(cur[bj], pv);
                float t[8];
#pragma unroll
                for (int e = 0; e < 4; ++e) { t[e] = sigmoidf_(acc[ai][bj][m][0][e] * rs) * pv[e]; t[4 + e] = sigmoidf_(acc[ai][bj][m][1][e] * rs) * pv[4 + e]; }
#pragma unroll
                for (int e = 0; e < 8; ++e) ssp += t[e] * t[e];
                *(u32x4*)(T + off) = pack8(t);
            }
            ssp += __shfl_xor(ssp, 16); ssp += __shfl_xor(ssp, 32);
            if (fq == 0) ss_add(tss, row, ssp);
            cur[0] = nxt[0]; cur[1] = nxt[1];
        }
    }
};
}

struct Args { const void* in[24]; float* out; unsigned char* ws; int ph_lo, ph_hi; };


__device__ __forceinline__ void tr_item(const float* __restrict__ W, int ldw, int col0, int k0, const float* __restrict__ gain, bf16_t* WT, int ldt, int drow0, bool zero, LAS float* scr, int lane) {
    const int c = lane & 7;
    if (zero) {
#pragma unroll
        for (int j = 0; j < 4; ++j) { const int n = (lane >> 3) + 8 * j; const unsigned zu = opaque_zero_u(); *(u32x4*)(WT + (size_t)(drow0 + n) * ldt + k0 + 8 * c) = (u32x4){zu, zu, zu, zu}; }
        return;
    }
    float wv[32];
    const float* wp = W + (size_t)(k0 + (lane >> 5)) * ldw + col0 + (lane & 31);
#pragma unroll
    for (int i = 0; i < 32; ++i) wv[i] = wp[(size_t)(2 * i) * ldw];
    const float gl = gain ? gain[k0 + lane] : 1.f;
#pragma unroll
    for (int i = 0; i < 32; ++i) { const int kk = 2 * i + (lane >> 5); scr[kk * 33 + (lane & 31)] = wv[i] * __shfl(gl, kk); }
    asm volatile("s_waitcnt lgkmcnt(0)" ::: "memory");
#pragma unroll
    for (int j = 0; j < 4; ++j) { const int n = (lane >> 3) + 8 * j; const LAS float* s = scr + (8 * c) * 33 + n;
        u32x4 o; o.x = cvt_pk(s[0 * 33], s[1 * 33]); o.y = cvt_pk(s[2 * 33], s[3 * 33]); o.z = cvt_pk(s[4 * 33], s[5 * 33]); o.w = cvt_pk(s[6 * 33], s[7 * 33]);
        *(u32x4*)(WT + (size_t)(drow0 + n) * ldt + k0 + 8 * c) = o; }
    asm volatile("s_waitcnt lgkmcnt(0)" ::: "memory");
}

__device__ __forceinline__ void p0_prologue(const Args& a, LAS unsigned char* lds, int tid, int lane, int wave, int G, int bx, size_t zo) {
    unsigned char* ws = a.ws + zo;
    LAS float* scr = (LAS float*)(lds + wave * 8704);
    const int gw = blockIdx.x * 8 + wave, NGW = G * 8;
    const float* ng = (const float*)a.in[3];
    constexpr int L_ITEMS = 9088, N_L = 4 * L_ITEMS, E_ITEMS = 2048, O_ITEMS = 1440, NITEMS = N_L + 2 * E_ITEMS + 2 * O_ITEMS;
    for (int it0 = gw; it0 < NITEMS; it0 += NGW) {
        int it = it0;
        const float* W; int ldw, col0, k0, ldt, drow0; const float* gain = nullptr; bf16_t* WT; bool zero = false;
        if (it < N_L) {
            const int i = it / L_ITEMS; int r = it % L_ITEMS; unsigned char* wl = ws + WS_W + (size_t)i * LW_STRIDE;
            if (r < 8448) {
                const int f = r / 4224; r %= 4224;
                if (r < 2816) { const int kb = r / 176, nb = r % 176, tile = nb >> 3, cb = nb & 7;
                    W = (const float*)a.in[cb < 4 ? 4 : 5] + (size_t)(i * 2 + f) * DM * DFF; ldw = DFF; col0 = tile * 128 + (cb & 3) * 32; k0 = kb * 64;
                    gain = ng + (i * 5 + (f ? 2 : 0)) * 1024; WT = (bf16_t*)(wl + (f ? OFF_WUP1 : OFF_WUP0)); ldt = 1024; drow0 = nb * 32;
                } else { r -= 2816; const int kb = r / 32, nb = r % 32;
                    W = (const float*)a.in[6] + (size_t)(i * 2 + f) * DFF * DM; ldw = DM; col0 = nb * 32; k0 = kb * 64; WT = (bf16_t*)(wl + (f ? OFF_WDN1 : OFF_WDN0)); ldt = DFF; drow0 = nb * 32; }
            } else { r -= 8448;
                if (r < 512) { const int kb = r / 32, nb = r % 32; W = (const float*)a.in[7] + (size_t)i * DM * DM; ldw = DM; col0 = nb * 32; k0 = kb * 64; gain = ng + (i * 5 + 3) * 1024; WT = (bf16_t*)(wl + OFF_WPG); ldt = 1024; drow0 = nb * 32; }
                else { r -= 512; const int kb = r / 32, nb = r % 32; W = (const float*)a.in[8] + (size_t)i * 256 * DM; ldw = DM; col0 = nb * 32; k0 = kb * 64; WT = (bf16_t*)(wl + OFF_WPP); ldt = 256; drow0 = nb * 32; }
            }
        } else {
            it -= N_L;
            if (it < 2 * E_ITEMS) { const int j = it / E_ITEMS; int r = it % E_ITEMS; unsigned char* we = ws + WS_WE + (size_t)j * WE_STRIDE;
                if (r < 1536) { const int kb = r / 96, nb = r % 96; W = (const float*)a.in[9] + (size_t)j * DM * 3072; ldw = 3072; col0 = nb * 32; k0 = kb * 64; gain = ng + ((2 * j) * 5 + 1) * 1024; WT = (bf16_t*)(we + OFF_WEIN); ldt = 1024; drow0 = nb * 32; }
                else { r -= 1536; const int kb = r / 32, nb = r % 32; W = (const float*)a.in[15] + (size_t)j * DM * DM; ldw = DM; col0 = nb * 32; k0 = kb * 64; WT = (bf16_t*)(we + OFF_WEOUT); ldt = 1024; drow0 = nb * 32; }
            } else { it -= 2 * E_ITEMS; const int j = it / O_ITEMS; int r = it % O_ITEMS; unsigned char* wo = ws + WS_WO + (size_t)j * WO_STRIDE;
                if (r < 384) { const int kb = r / 24, nb = r % 24; zero = nb >= 22; W = (const float*)a.in[16] + (size_t)j * DM * 704; ldw = 704; col0 = nb * 32; k0 = kb * 64; gain = ng + ((2 * j + 1) * 5 + 1) * 1024; WT = (bf16_t*)(wo + OFF_WMIN); ldt = 1024; drow0 = nb * 32; }
                else if ((r -= 384) < 288) { const int kb = r / 48, nb = r % 48; W = (const float*)a.in[19] + (size_t)j * 384 * 1536; ldw = 1536; col0 = nb * 32; k0 = kb * 64; gain = (const float*)a.in[17] + j * 384; WT = (bf16_t*)(wo + OFF_WQB); ldt = 384; drow0 = nb * 32; }
                else if ((r -= 288) < 256) { const int kb = r / 64, nb = r % 64; W = (const float*)a.in[20] + (size_t)j * 256 * 2048; ldw = 2048; col0 = nb * 32; k0 = kb * 64; gain = (const float*)a.in[18] + j * 256; WT = (bf16_t*)(wo + OFF_WKVB); ldt = 256; drow0 = nb * 32; }
                else { r -= 256; const int kb = r / 32, nb = r % 32; W = (const float*)a.in[23] + (size_t)j * DM * DM; ldw = DM; col0 = nb * 32; k0 = kb * 64; WT = (bf16_t*)(wo + OFF_WMOUT); ldt = 1024; drow0 = nb * 32; }
            }
        }
        tr_item(W, ldw, col0, k0, gain, WT, ldt, drow0, zero, scr, lane);
    }
    {
        const float* x = (const float*)a.in[0]; bf16_t* XB = (bf16_t*)(ws + WS_XB); ss_t* SS = (ss_t*)(ws + WS_SS);
        for (int row = gw; row < M; row += NGW) {
            float ssp = 0.f;
#pragma unroll
            for (int j = 0; j < 2; ++j) { const int c = lane + 64 * j; const size_t off = (size_t)row * DM + 8 * c;
                const f32x4 v0 = *(const f32x4*)(x + off), v1 = *(const f32x4*)(x + off + 4);
                u32x4 w; w.x = cvt_pk(v0[0], v0[1]); w.y = cvt_pk(v0[2], v0[3]); w.z = cvt_pk(v1[0], v1[1]); w.w = cvt_pk(v1[2], v1[3]);
                *(u32x4*)(XB + off) = w;
                ssp += (v0[0] * v0[0] + v0[1] * v0[1]) + (v0[2] * v0[2] + v0[3] * v0[3]) + (v1[0] * v1[0] + v1[1] * v1[1]) + (v1[2] * v1[2] + v1[3] * v1[3]); }
            ssp = wave_sum(ssp);
            if (lane == 0) SS[row] = ss_fix(ssp);
        }
        f32x4* z = (f32x4*)(SS + M);
        for (size_t i = (size_t)blockIdx.x * 512 + tid; i < (size_t)28 * M / 2; i += (size_t)G * 512) { const float zz = opaque_zero(); z[i] = (f32x4){zz, zz, zz, zz}; }
        if (blockIdx.x == 0) { const float* lr = (const float*)a.in[13]; float* LB = (float*)(ws + WS_LB);
            const float r0 = lr[tid], r1 = lr[512 + tid]; const float sm1 = 1.f / (1.f + expf(r0 - r1));
            LB[tid] = 0.f; LB[512 + tid] = fminf(fmaxf(sm1, 0.f), 0.999f); }
    }
}

__device__ __forceinline__ void p_convert(const float* p, bf16_t* PB, int tid, int G) {
    for (size_t i = (size_t)blockIdx.x * 512 + tid; i < (size_t)M * 256 / 8; i += (size_t)G * 512) {
        const f32x4 v0 = *(const f32x4*)(p + i * 8), v1 = *(const f32x4*)(p + i * 8 + 4);
        u32x4 w; w.x = cvt_pk(v0[0], v0[1]); w.y = cvt_pk(v0[2], v0[3]); w.z = cvt_pk(v1[0], v1[1]); w.w = cvt_pk(v1[2], v1[3]);
        *(u32x4*)(PB + i * 8) = w;
    }
}
__device__ __forceinline__ void ple_finalize(float* xout, const bf16_t* T, const ss_t* tss, const float* g4, bf16_t* XB, ss_t* ssn, int lane, int wave, int G) {
    const int gw = blockIdx.x * 8 + wave, NGW = G * 8;
    f32x4 gg[2][2];
#pragma unroll
    for (int j = 0; j < 2; ++j) { const int c = lane + 64 * j; gg[j][0] = *(const f32x4*)(g4 + 8 * c); gg[j][1] = *(const f32x4*)(g4 + 8 * c + 4); }
    for (int row = gw; row < M; row += 2 * NGW) {
        u32x4 tv[2][2], xv[2][2]; ss_t sv[2];
#pragma unroll
        for (int r = 0; r < 2; ++r) { const int rr = row + r * NGW; sv[r] = tss[rr];
#pragma unroll
            for (int j = 0; j < 2; ++j) { const int c = lane + 64 * j; const size_t off = (size_t)rr * DM + 8 * c; tv[r][j] = *(const u32x4*)(T + off); xv[r][j] = *(const u32x4*)(XB + off); } }
#pragma unroll
        for (int r = 0; r < 2; ++r) { const int rr = row + r * NGW;
            const float rs = rsqrtf((float)(long long)sv[r] * (1.f / 1048576.f) * (1.f / 1024.f) + EPS); float ssp = 0.f;
#pragma unroll
            for (int j = 0; j < 2; ++j) { const int c = lane + 64 * j; const size_t off = (size_t)rr * DM + 8 * c;
                float t[8], v[8]; unpack8(tv[r][j], t); unpack8(xv[r][j], v);
#pragma unroll
                for (int e = 0; e < 4; ++e) { v[e] += t[e] * rs * gg[j][0][e]; v[4 + e] += t[4 + e] * rs * gg[j][1][e]; }
                if (xout) { *(f32x4*)(xout + off) = (f32x4){v[0], v[1], v[2], v[3]}; *(f32x4*)(xout + off + 4) = (f32x4){v[4], v[5], v[6], v[7]}; }
                *(u32x4*)(XB + off) = pack8(v);
#pragma unroll
                for (int e = 0; e < 8; ++e) ssp += v[e] * v[e]; }
            ssp = wave_sum(ssp);
            if (lane == 0) ssn[rr] = ss_fix(ssp); }
    }
}

__device__ __forceinline__ void gmlp_unit(LAS unsigned char* lds, int unit, const bf16_t* Z, const float* w_s, const float* b_s, const float* vnorm, bf16_t* MIX, int tid, bool stage_w) {
    asm volatile("" : "+v"(tid));
    const int h = unit & 7, bc = unit >> 3;
    const size_t row0 = (size_t)bc * 128;
    LAS bf16_t* Wb = (LAS bf16_t*)lds;
    LAS bf16_t* VnT = (LAS bf16_t*)(lds + 34816);
    const int lane = tid & 63, wave = rfl(tid >> 6), fr = lane & 15, fq = lane >> 4;
    {
        const int s = tid >> 2, part = tid & 3;
        const bf16_t* vp = Z + (row0 + s) * 2560 + 512 + h * 64 + part * 16;
        float v[16]; unpack8(*(const u32x4*)vp, v); unpack8(*(const u32x4*)(vp + 8), v + 8);
        float ssp = 0.f;
#pragma unroll
        for (int e = 0; e < 16; ++e) ssp += v[e] * v[e];
        ssp += __shfl_xor(ssp, 1); ssp += __shfl_xor(ssp, 2);
        const float rs = rsqrtf(ssp * (1.f / 64.f) + EPS);
#pragma unroll
        for (int e = 0; e < 16; e += 2) { const unsigned w = cvt_pk(v[e] * rs * vnorm[h * 64 + part * 16 + e], v[e + 1] * rs * vnorm[h * 64 + part * 16 + e + 1]);
            VnT[(part * 16 + e) * 136 + s] = (bf16_t)(w & 0xffffu); VnT[(part * 16 + e + 1) * 136 + s] = (bf16_t)(w >> 16); }
        if (stage_w) {
            const f32x4* wp = (const f32x4*)(w_s + (size_t)h * 128 * 128);
            f32x4 wv[8];
#pragma unroll
            for (int k = 0; k < 8; ++k) wv[k] = wp[tid + 512 * k];
#pragma unroll
            for (int k = 0; k < 8; ++k) { const int i4 = (tid + 512 * k) * 4, t = i4 >> 7, s2 = i4 & 127;
                u32x2 w; w.x = cvt_pk(s2 <= t ? wv[k][0] : 0.f, s2 + 1 <= t ? wv[k][1] : 0.f); w.y = cvt_pk(s2 + 2 <= t ? wv[k][2] : 0.f, s2 + 3 <= t ? wv[k][3] : 0.f);
                *(LAS u32x2*)(Wb + t * 136 + s2) = w; }
        }
    }
    __syncthreads();
    {
        f32x4 acc[4];
#pragma unroll
        for (int nt = 0; nt < 4; ++nt) acc[nt] = (f32x4){0.f, 0.f, 0.f, 0.f};
#pragma unroll
        for (int ks = 0; ks < 4; ++ks) {
            if (32 * ks <= 16 * wave + 15) {
                const bf16x8 bv = *(const LAS bf16x8*)(Wb + (16 * wave + fr) * 136 + 32 * ks + 8 * fq);
#pragma unroll
                for (int nt = 0; nt < 4; ++nt) {
                    const bf16x8 av = *(const LAS bf16x8*)(VnT + (16 * nt + fr) * 136 + 32 * ks + 8 * fq);
                    acc[nt] = __builtin_amdgcn_mfma_f32_16x16x32_bf16(av, bv, acc[nt], 0, 0, 0);
                }
            }
        }
        const int t = 16 * wave + fr;
        const float bias = b_s[h * 128 + t];
#pragma unroll
        for (int nt = 0; nt < 4; ++nt) {
            const int e0 = 16 * nt + 4 * fq;
            const u32x2 uw = *(const u32x2*)(Z + (row0 + t) * 2560 + h * 64 + e0);
            const float o0 = bf_lo(uw.x) * (acc[nt][0] + bias), o1 = bf_hi(uw.x) * (acc[nt][1] + bias), o2 = bf_lo(uw.y) * (acc[nt][2] + bias), o3 = bf_hi(uw.y) * (acc[nt][3] + bias);
            u32x2 ow; ow.x = cvt_pk(o0, o1); ow.y = cvt_pk(o2, o3);
            *(u32x2*)(MIX + (row0 + t) * DM + h * 64 + e0) = ow;
        }
    }
    __syncthreads();
}

__device__ __forceinline__ bf16_t f2bf(float x) { return (bf16_t)(cvt_pk(x, 0.f) & 0xffffu); }
#define HBAR() asm volatile("s_waitcnt lgkmcnt(0)\n\ts_barrier" ::: "memory")
__device__ __forceinline__ void hgrn_unit(LAS unsigned char* lds, int unit, const bf16_t* Z, const float* LF, bf16_t* OH, int tid, int lane, int wave) {
    asm volatile("" : "+v"(tid));
    lane = tid & 63;
    const int es = unit & 7, h = (unit >> 3) & 3, b = unit >> 5;
    LAS float* LFs = (LAS float*)lds;
    LAS bf16_t* Qs = (LAS bf16_t*)(lds + 32768);
    LAS bf16_t* Aq = (LAS bf16_t*)(lds + 49152);
    LAS bf16_t* Bk = (LAS bf16_t*)(lds + 66560);
    LAS bf16_t* Aqe = (LAS bf16_t*)(lds + 83968);
    LAS bf16_t* KKt = (LAS bf16_t*)(lds + 101376);
    LAS bf16_t* Vt = (LAS bf16_t*)(lds + 119808);
    LAS bf16_t* Pm = (LAS bf16_t*)(lds + 122112);
    LAS bf16_t* St = (LAS bf16_t*)(lds + 131328);
    LAS float* Gs = (LAS float*)(lds + 135680);
    LAS float* QS = (LAS float*)(lds + 136192);
    const int fr = lane & 15, fq = lane >> 4;
    for (int i = tid; i < 16 * 136 / 2; i += 512) ((LAS unsigned*)St)[i] = 0u;
    f32x4 st = (f32x4){0.f, 0.f, 0.f, 0.f};
    const int lt = tid >> 3, lpart = tid & 7;
    const int vt2 = tid >> 1, vpp = tid & 1;
    const int cd = tid & 127, ctq = tid >> 7;
    const size_t rowb = (size_t)b * SEQ;
    f32x4 plf[4]; u32x4 pq[2]; u32x4 pv = (u32x4){0u, 0u, 0u, 0u};
    {
        const float* lp = LF + (rowb + lt) * 512 + h * 128 + lpart * 16;
        const bf16_t* qp = Z + (rowb + lt) * 2560 + 1024 + h * 128 + lpart * 16;
#pragma unroll
        for (int j = 0; j < 4; ++j) plf[j] = *(const f32x4*)(lp + 4 * j);
        pq[0] = *(const u32x4*)qp; pq[1] = *(const u32x4*)(qp + 8);
        if (tid < 128) pv = *(const u32x4*)(Z + (rowb + vt2) * 2560 + 1536 + h * 128 + es * 16 + vpp * 8);
    }
#pragma unroll 1
    for (int c = 0; c < SEQ / 64; ++c) {
        const size_t row0 = rowb + (size_t)c * 64;
#pragma unroll
        for (int j = 0; j < 4; ++j) *(LAS f32x4*)(LFs + lt * 128 + lpart * 16 + 4 * j) = plf[j];
        *(LAS u32x4*)(Qs + lt * 128 + lpart * 16) = pq[0]; *(LAS u32x4*)(Qs + lt * 128 + lpart * 16 + 8) = pq[1];
        if (tid < 128) { const unsigned ww[4] = {pv.x, pv.y, pv.z, pv.w};
#pragma unroll
            for (int j = 0; j < 4; ++j) { Vt[(vpp * 8 + 2 * j) * 72 + vt2] = (bf16_t)(ww[j] & 0xffffu); Vt[(vpp * 8 + 2 * j + 1) * 72 + vt2] = (bf16_t)(ww[j] >> 16); } }
        HBAR();
        if (c + 1 < SEQ / 64) {
            const float* lp = LF + (row0 + 64 + lt) * 512 + h * 128 + lpart * 16;
            const bf16_t* qp = Z + (row0 + 64 + lt) * 2560 + 1024 + h * 128 + lpart * 16;
#pragma unroll
            for (int j = 0; j < 4; ++j) plf[j] = *(const f32x4*)(lp + 4 * j);
            pq[0] = *(const u32x4*)qp; pq[1] = *(const u32x4*)(qp + 8);
            if (tid < 128) pv = *(const u32x4*)(Z + (row0 + 64 + vt2) * 2560 + 1536 + h * 128 + es * 16 + vpp * 8);
        }
        float L[16]; float run = 0.f;
#pragma unroll
        for (int i = 0; i < 16; ++i) { run += LFs[(16 * ctq + i) * 128 + cd]; L[i] = run; }
        QS[ctq * 128 + cd] = run;
        HBAR();
        {
            const float q0 = QS[cd], q1 = QS[128 + cd], q2 = QS[256 + cd], q3 = QS[384 + cd];
            const float bref = q0 + q1, tot = (q0 + q1) + (q2 + q3);
            const float off = ctq == 0 ? 0.f : ctq == 1 ? q0 : ctq == 2 ? q0 + q1 : (q0 + q1) + q2;
            unsigned kkp[8];
            float lfv[16], qvv[16];
#pragma unroll
            for (int i = 0; i < 16; ++i) { const int t = 16 * ctq + i; lfv[i] = LFs[t * 128 + cd]; qvv[i] = bf_lo((unsigned)Qs[t * 128 + cd]); }
            const float ebref = __expf(bref), etb = __expf(tot - bref);
#pragma unroll
            for (int i = 0; i < 16; ++i) {
                const int t = 16 * ctq + i;
                const float B = L[i] + off;
                const float E = __expf(B - bref), Ei = fast_rcp(E);
                const float kv = 1.f - __expf(lfv[i]);
                Aq[t * 136 + cd] = f2bf(qvv[i] * E);
                Bk[t * 136 + cd] = f2bf(kv * Ei);
                Aqe[t * 136 + cd] = f2bf(qvv[i] * E * ebref);
                L[i] = kv * Ei * etb;
            }
#pragma unroll
            for (int i = 0; i < 8; ++i) kkp[i] = cvt_pk(L[2 * i], L[2 * i + 1]);
            *(LAS u32x4*)(KKt + cd * 72 + 16 * ctq) = (u32x4){kkp[0], kkp[1], kkp[2], kkp[3]};
            *(LAS u32x4*)(KKt + cd * 72 + 16 * ctq + 8) = (u32x4){kkp[4], kkp[5], kkp[6], kkp[7]};
            if (ctq == 0) Gs[cd] = __expf(tot);
        }
        HBAR();
        {
            const int tb = wave & 3, sbp = wave >> 2;
#pragma unroll
            for (int k2 = 0; k2 < 2; ++k2) {
                const int sb = 2 * sbp + k2;
                f32x4 acc = (f32x4){0.f, 0.f, 0.f, 0.f};
                if (sb <= tb) {
#pragma unroll
                    for (int ks = 0; ks < 4; ++ks) {
                        const bf16x8 av = *(const LAS bf16x8*)(Aq + (16 * tb + fr) * 136 + 32 * ks + 8 * fq);
                        const bf16x8 bv = *(const LAS bf16x8*)(Bk + (16 * sb + fr) * 136 + 32 * ks + 8 * fq);
                        acc = __builtin_amdgcn_mfma_f32_16x16x32_bf16(av, bv, acc, 0, 0, 0);
                    }
                    if (sb == tb) {
#pragma unroll
                        for (int i = 0; i < 4; ++i) if (fr > 4 * fq + i) acc[i] = 0.f;
                    }
                }
#pragma unroll
                for (int i = 0; i < 4; ++i) Pm[(16 * tb + 4 * fq + i) * 72 + 16 * sb + fr] = f2bf(acc[i]);
            }
        }
        HBAR();
        if (wave < 4) {
            const int tb = wave;
            f32x4 acc = (f32x4){0.f, 0.f, 0.f, 0.f};
#pragma unroll
            for (int ks = 0; ks < 2; ++ks) {
                const bf16x8 av = *(const LAS bf16x8*)(Pm + (16 * tb + fr) * 72 + 32 * ks + 8 * fq);
                const bf16x8 bv = *(const LAS bf16x8*)(Vt + fr * 72 + 32 * ks + 8 * fq);
                acc = __builtin_amdgcn_mfma_f32_16x16x32_bf16(av, bv, acc, 0, 0, 0);
            }
#pragma unroll
            for (int ks = 0; ks < 4; ++ks) {
                const bf16x8 av = *(const LAS bf16x8*)(Aqe + (16 * tb + fr) * 136 + 32 * ks + 8 * fq);
                const bf16x8 bv = *(const LAS bf16x8*)(St + fr * 136 + 32 * ks + 8 * fq);
                acc = __builtin_amdgcn_mfma_f32_16x16x32_bf16(av, bv, acc, 0, 0, 0);
            }
#pragma unroll
            for (int i = 0; i < 4; ++i) OH[(row0 + 16 * tb + 4 * fq + i) * 512 + h * 128 + es * 16 + fr] = f2bf(acc[i]);
        }
        {
            const f32x4 g = *(const LAS f32x4*)(Gs + 16 * wave + 4 * fq);
            st = st * g;
#pragma unroll
            for (int ks = 0; ks < 2; ++ks) {
                const bf16x8 av = *(const LAS bf16x8*)(KKt + (16 * wave + fr) * 72 + 32 * ks + 8 * fq);
                const bf16x8 bv = *(const LAS bf16x8*)(Vt + fr * 72 + 32 * ks + 8 * fq);
                st = __builtin_amdgcn_mfma_f32_16x16x32_bf16(av, bv, st, 0, 0, 0);
            }
        }
        HBAR();
        { u32x2 w; w.x = cvt_pk(st[0], st[1]); w.y = cvt_pk(st[2], st[3]); *(LAS u32x2*)(St + fr * 136 + 16 * wave + 4 * fq) = w; }
    }
    HBAR();
}
#undef HBAR
__device__ __forceinline__ void hgrn_onorm(const bf16_t* OH, const bf16_t* Z, const float* gain, bf16_t* MIX, int lane, int wave, int G) {
    const int gw = blockIdx.x * 8 + wave, NGW = G * 8;
    const int e0 = (8 * lane) & 127;
    const f32x4 g0 = *(const f32x4*)(gain + e0), g1 = *(const f32x4*)(gain + e0 + 4);
    for (int row = gw; row < M; row += 2 * NGW) {
        u32x4 ov[2], zv[2];
#pragma unroll
        for (int r = 0; r < 2; ++r) { const size_t rr = (size_t)(row + r * NGW); ov[r] = *(const u32x4*)(OH + rr * 512 + 8 * lane); zv[r] = *(const u32x4*)(Z + rr * 2560 + 2048 + 8 * lane); }
#pragma unroll
        for (int r = 0; r < 2; ++r) { const size_t rr = (size_t)(row + r * NGW);
            float v[8]; unpack8(ov[r], v);
            float ssp = 0.f;
#pragma unroll
            for (int e = 0; e < 8; ++e) ssp += v[e] * v[e];
            ssp += __shfl_xor(ssp, 1); ssp += __shfl_xor(ssp, 2); ssp += __shfl_xor(ssp, 4); ssp += __shfl_xor(ssp, 8);
            const float rs = rsqrtf(ssp * (1.f / 128.f) + EPS);
            float sg[8]; unpack8(zv[r], sg);
            float o[8];
#pragma unroll
            for (int e = 0; e < 4; ++e) { o[e] = v[e] * rs * g0[e] * sg[e]; o[4 + e] = v[4 + e] * rs * g1[e] * sg[4 + e]; }
            *(u32x4*)(MIX + rr * DM + 512 + 8 * lane) = pack8(o); }
    }
}

constexpr float QSCALE = 0.07216878364870323f * 1.4426950408889634f;
__device__ __forceinline__ void mla_prep_unit(LAS unsigned char* lds, int tb, bf16_t* Q, bf16_t* KV, const bf16_t* ZC, bf16_t* VT, const int* positions, const float* qnorm, const float* knorm, int tid, int lane, int wave) {
    asm volatile("" : "+v"(tid));
    lane = tid & 63;
    const size_t r0 = (size_t)tb * 64; const int b = (int)(r0 / SEQ), s0 = (int)(r0 % SEQ);
    LAS float* RS = (LAS float*)lds;
    {
        const int tok = tid >> 3, part = tid & 7;
        const bf16_t* cp = ZC + (r0 + tok) * 768 + 384 + part * 32;
        float ssp = 0.f;
#pragma unroll
        for (int c = 0; c < 4; ++c) { float v[8]; unpack8(*(const u32x4*)(cp + 8 * c), v);
#pragma unroll
            for (int j = 0; j < 8; ++j) ssp += v[j] * v[j]; }
        ssp += __shfl_xor(ssp, 1); ssp += __shfl_xor(ssp, 2); ssp += __shfl_xor(ssp, 4);
        if (part == 0) RS[tok] = rsqrtf(ssp * (1.f / 256.f) + EPS);
    }
    __syncthreads();
#pragma unroll 4
    for (int k = 0; k < 16; ++k) {
        const int ci = tid + 512 * k, tok = ci >> 7, c8 = (ci & 127) * 8;
        bf16_t* vp = VT + (r0 + tok) * 1024 + c8;
        float v[8]; unpack8(*(const u32x4*)vp, v);
        const float rk = RS[tok];
#pragma unroll
        for (int j = 0; j < 8; ++j) v[j] *= rk;
        *(u32x4*)vp = pack8(v);
    }
    const int half = lane >> 5, rl = lane & 31; const bool act = rl < 24;
    const float invf = exp2f(-(float)rl * 0.4152410118609203f);
    float qg[8], kg[8];
#pragma unroll
    for (int j = 0; j < 8; ++j) { qg[j] = act ? qnorm[8 * rl + j] : 0.f; kg[j] = act ? knorm[8 * rl + j] : 0.f; }
    const bool ropeA = (rl >= 16 && rl < 20), ropeB = (rl >= 20 && rl < 24);
    const int rla = act ? rl : 0;
    u32x4 qc[4], kc[4], qn[4], kn[4]; int pc, pn;
    {
        const size_t row = r0 + wave * 8;
        pc = positions[row];
#pragma unroll
        for (int hp = 0; hp < 4; ++hp) { const int head = 2 * hp + half;
            qc[hp] = *(const u32x4*)(Q + row * 1536 + head * 192 + 8 * rla);
            kc[hp] = (rl >= 16 && act) ? *(const u32x4*)(ZC + row * 768 + 640 + 8 * (rl - 16)) : *(const u32x4*)(KV + row * 1536 + head * 192 + 8 * rla); }
    }
    pn = pc;
#pragma unroll
    for (int hp = 0; hp < 4; ++hp) { qn[hp] = qc[hp]; kn[hp] = kc[hp]; }
#pragma unroll 1
    for (int rr = 0; rr < 8; ++rr) {
        const size_t row = r0 + wave * 8 + rr;
        if (rr + 1 < 8) {
            const size_t rown = row + 1;
            pn = positions[rown];
#pragma unroll
            for (int hp = 0; hp < 4; ++hp) { const int head = 2 * hp + half;
                qn[hp] = *(const u32x4*)(Q + rown * 1536 + head * 192 + 8 * rla);
                kn[hp] = (rl >= 16 && act) ? *(const u32x4*)(ZC + rown * 768 + 640 + 8 * (rl - 16)) : *(const u32x4*)(KV + rown * 1536 + head * 192 + 8 * rla); }
        }
        const float ang = (float)pc * invf;
        float sn, cs; sincosf(ang, &sn, &cs);
        float cv[8], sv[8];
#pragma unroll
        for (int j = 0; j < 8; ++j) { const int src = (lane & 32) + 8 * (rl & 3) + j; cv[j] = __shfl(cs, src); sv[j] = __shfl(sn, src); }
        const float rk = RS[wave * 8 + rr];
#pragma unroll
        for (int hp = 0; hp < 4; ++hp) { const int head = 2 * hp + half;
            bf16_t* qp = Q + row * 1536 + head * 192 + 8 * rl;
            float v[8]; unpack8(qc[hp], v);
            if (!act) {
#pragma unroll
                for (int j = 0; j < 8; ++j) v[j] = 0.f; }
            float ssp = 0.f;
#pragma unroll
            for (int j = 0; j < 8; ++j) ssp += v[j] * v[j];
            ssp += __shfl_xor(ssp, 1); ssp += __shfl_xor(ssp, 2); ssp += __shfl_xor(ssp, 4); ssp += __shfl_xor(ssp, 8); ssp += __shfl_xor(ssp, 16);
            const float rs = rsqrtf(ssp * (1.f / 192.f) + EPS);
#pragma unroll
            for (int j = 0; j < 8; ++j) v[j] = v[j] * rs * qg[j];
#pragma unroll
            for (int j = 0; j < 8; ++j) { const float pr = __shfl_xor(v[j], 4); if (ropeA) v[j] = v[j] * cv[j] - pr * sv[j]; else if (ropeB) v[j] = v[j] * cv[j] + pr * sv[j]; }
#pragma unroll
            for (int j = 0; j < 8; ++j) v[j] *= QSCALE;
            if (act) *(u32x4*)qp = pack8(v);
        }
#pragma unroll
        for (int hp = 0; hp < 4; ++hp) { const int head = 2 * hp + half;
            bf16_t* kp = KV + row * 1536 + head * 192 + 8 * rl;
            float v[8]; unpack8(kc[hp], v);
            if (rl < 16) {
#pragma unroll
                for (int j = 0; j < 8; ++j) v[j] *= rk; }
            else if (!act) {
#pragma unroll
                for (int j = 0; j < 8; ++j) v[j] = 0.f; }
            float ssp = 0.f;
#pragma unroll
            for (int j = 0; j < 8; ++j) ssp += v[j] * v[j];
            ssp += __shfl_xor(ssp, 1); ssp += __shfl_xor(ssp, 2); ssp += __shfl_xor(ssp, 4); ssp += __shfl_xor(ssp, 8); ssp += __shfl_xor(ssp, 16);
            const float rs = rsqrtf(ssp * (1.f / 192.f) + EPS);
#pragma unroll
            for (int j = 0; j < 8; ++j) v[j] = v[j] * rs * kg[j];
#pragma unroll
            for (int j = 0; j < 8; ++j) { const float pr = __shfl_xor(v[j], 4); if (ropeA) v[j] = v[j] * cv[j] - pr * sv[j]; else if (ropeB) v[j] = v[j] * cv[j] + pr * sv[j]; }
            if (act) *(u32x4*)kp = pack8(v);
        }
        pc = pn;
#pragma unroll
        for (int hp = 0; hp < 4; ++hp) { qc[hp] = qn[hp]; kc[hp] = kn[hp]; }
    }
    __syncthreads();
}

__device__ __forceinline__ int crow(int r, int hi) { return (r & 3) + 8 * (r >> 2) + 4 * hi; }
__device__ __forceinline__ void attn_unit(LAS unsigned char* lds, int bh, int qb, const bf16_t* QN, const bf16_t* KV, const bf16_t* VT, bf16_t* AO, int lane, int wid) {
    asm volatile("" : "+v"(lane));
    const int r32 = lane & 31, hi = lane >> 5;
    const int b = bh >> 3, h = bh & 7;
    const size_t rowbase = (size_t)b * SEQ;
    const int qw0 = qb * 256 + wid * 32;
    bf16x8 qf[12];
    {
        const bf16_t* qp = QN + (rowbase + qw0 + r32) * 1536 + h * 192 + 8 * hi;
#pragma unroll
        for (int ks = 0; ks < 12; ++ks) qf[ks] = *(const bf16x8*)(qp + 16 * ks);
    }
    const float zf = opaque_zero();
    f32x16 o[4];
#pragma unroll
    for (int d = 0; d < 4; ++d)
#pragma unroll
        for (int r = 0; r < 16; ++r) o[d][r] = zf;
    float m_run = -1e30f, l_run = 0.f;
    const int NT = 4 * qb + 4;
    const bf16_t* ksrc = KV + rowbase * 1536 + h * 192;
    int koff[3];
#pragma unroll
    for (int i_ = 0; i_ < 3; ++i_) { const int idx = 64 * (wid + 8 * i_) + lane, r = idx / 24, cs = idx - 24 * r, c = (cs & ~7) | ((cs ^ (r >> 1)) & 7); koff[i_] = r * 1536 + 8 * c; }
    int okj[4];
#pragma unroll
    for (int j_ = 0; j_ < 4; ++j_) okj[j_] = r32 * 384 + ((((2 * j_ + hi) ^ (r32 >> 1)) & 7) * 16);
    const bf16_t* vsrc = VT + (rowbase + (lane >> 4)) * 1024 + h * 128 + 8 * ((lane & 15) ^ ((lane >> 4) << 2));
#define ATT_ISSUE(t_, st_) do { LAS unsigned char* Ks_ = lds + (st_) * 40960; LAS unsigned char* Vs_ = Ks_ + 24576; \
        _Pragma("unroll") for (int i_ = 0; i_ < 3; ++i_) { const int c_ = wid + 8 * i_; \
            __builtin_amdgcn_global_load_lds((const unsigned*)(ksrc + (size_t)(t_) * 64 * 1536 + koff[i_]), (LAS unsigned*)(Ks_ + c_ * 1024), 16, 0, 0); } \
        _Pragma("unroll") for (int i_ = 0; i_ < 2; ++i_) { const int p_ = wid + 8 * i_; \
            __builtin_amdgcn_global_load_lds((const unsigned*)(vsrc + (size_t)((t_) * 64 + 4 * p_) * 1024), (LAS unsigned*)(Vs_ + p_ * 1024), 16, 0, 0); } } while (0)
    const int tq = (lane & 15) >> 2, tp = lane & 3, tdg = (lane >> 4) & 1;
    ATT_ISSUE(0, 0);
    for (int t = 0; t < NT; ++t) {
        asm volatile("s_waitcnt vmcnt(0) lgkmcnt(0)\n\ts_barrier" ::: "memory");
        if (t + 1 < NT) ATT_ISSUE(t + 1, (t + 1) & 1);
        const int kv0 = 64 * t;
        if (kv0 <= qw0 + 31) {
            const LAS unsigned char* Ks = lds + (t & 1) * 40960; const LAS unsigned char* Vs = Ks + 24576;
            f32x16 p0, p1;
#pragma unroll
            for (int r = 0; r < 16; ++r) { p0[r] = zf; p1[r] = zf; }
#pragma unroll
            for (int ks = 0; ks < 12; ++ks) {
                const LAS unsigned char* kp = Ks + okj[ks & 3] + (ks >> 2) * 128;
                const bf16x8 k0 = *(const LAS bf16x8*)kp, k1 = *(const LAS bf16x8*)(kp + 12288);
                p0 = __builtin_amdgcn_mfma_f32_32x32x16_bf16(k0, qf[ks], p0, 0, 0, 0);
                p1 = __builtin_amdgcn_mfma_f32_32x32x16_bf16(k1, qf[ks], p1, 0, 0, 0);
            }
            if (kv0 + 63 > qw0) {
                const int qi = qw0 + r32;
#pragma unroll
                for (int r = 0; r < 16; ++r) { const int kvi = kv0 + crow(r, hi); if (kvi > qi) p0[r] = -1e30f; if (kvi + 32 > qi) p1[r] = -1e30f; }
            }
            float mx = fmaxf(p0[0], p1[0]);
#pragma unroll
            for (int r = 1; r < 16; ++r) mx = fmaxf(mx, fmaxf(p0[r], p1[r]));
            mx = fmaxf(mx, __shfl_xor(mx, 32));
            if (__any(mx > m_run + 8.f)) {
                const float mn = fmaxf(m_run, mx);
                const float alpha = __builtin_amdgcn_exp2f(m_run - mn);
                m_run = mn; l_run *= alpha;
#pragma unroll
                for (int d = 0; d < 4; ++d)
#pragma unroll
                    for (int r = 0; r < 16; ++r) o[d][r] *= alpha;
            }
            float sum = 0.f;
#pragma unroll
            for (int r = 0; r < 16; ++r) { p0[r] = __builtin_amdgcn_exp2f(p0[r] - m_run); p1[r] = __builtin_amdgcn_exp2f(p1[r] - m_run); sum += p0[r] + p1[r]; }
            l_run += sum;
            bf16x8 pf[4];
            {
                u32x4 w;
                w.x = cvt_pk(p0[0], p0[1]); w.y = cvt_pk(p0[2], p0[3]); w.z = cvt_pk(p0[4], p0[5]); w.w = cvt_pk(p0[6], p0[7]); pf[0] = __builtin_bit_cast(bf16x8, w);
                w.x = cvt_pk(p0[8], p0[9]); w.y = cvt_pk(p0[10], p0[11]); w.z = cvt_pk(p0[12], p0[13]); w.w = cvt_pk(p0[14], p0[15]); pf[1] = __builtin_bit_cast(bf16x8, w);
                w.x = cvt_pk(p1[0], p1[1]); w.y = cvt_pk(p1[2], p1[3]); w.z = cvt_pk(p1[4], p1[5]); w.w = cvt_pk(p1[6], p1[7]); pf[2] = __builtin_bit_cast(bf16x8, w);
                w.x = cvt_pk(p1[8], p1[9]); w.y = cvt_pk(p1[10], p1[11]); w.z = cvt_pk(p1[12], p1[13]); w.w = cvt_pk(p1[14], p1[15]); pf[3] = __builtin_bit_cast(bf16x8, w);
            }
#pragma unroll
            for (int d = 0; d < 4; ++d)
#pragma unroll
                for (int i = 0; i < 4; ++i) {
                    const LAS unsigned char* va = Vs + (16 * i + 4 * hi + tq) * 256 + (4 * (d ^ tq) + 2 * tdg + (tp >> 1)) * 16 + (tp & 1) * 8;
                    const s16x4 lo4 = __builtin_bit_cast(s16x4, __builtin_amdgcn_ds_read_tr16_b64_v4i16((LAS v4i16_t*)va));
                    const s16x4 hi4 = __builtin_bit_cast(s16x4, __builtin_amdgcn_ds_read_tr16_b64_v4i16((LAS v4i16_t*)(va + 8 * 256)));
                    const bf16x8 vf = (bf16x8){lo4[0], lo4[1], lo4[2], lo4[3], hi4[0], hi4[1], hi4[2], hi4[3]};
                    o[d] = __builtin_amdgcn_mfma_f32_32x32x16_bf16(vf, pf[i], o[d], 0, 0, 0);
                }
        }
    }
#undef ATT_ISSUE
    const float lt = l_run + __shfl_xor(l_run, 32);
    const float inv = 1.f / lt;
    bf16_t* op = AO + (rowbase + qw0 + r32) * DM + h * 128;
#pragma unroll
    for (int d = 0; d < 4; ++d)
#pragma unroll
        for (int g4 = 0; g4 < 4; ++g4) {
            u32x2 w; w.x = cvt_pk(o[d][4 * g4] * inv, o[d][4 * g4 + 1] * inv); w.y = cvt_pk(o[d][4 * g4 + 2] * inv, o[d][4 * g4 + 3] * inv);
            *(u32x2*)(op + 32 * d + 8 * g4 + 4 * hi) = w;
        }
}

#define XB_TMO      128
#define XB_XCNT(j)  (256  + 64 * (j))
#define XB_XSUB(j)  (1280 + 64 * (j))
#define XB_XGEN(j)  (2304 + 64 * (j))
#define XB_TOP      3328
#define XB_TOPGEN   3392
#define XCD_BAR_WORDS 3456
#define XB_SPIN_CAP (1u << 20)
__device__ __forceinline__ unsigned xb_ld(unsigned* p)              { return __hip_atomic_load(p, __ATOMIC_RELAXED, __HIP_MEMORY_SCOPE_AGENT); }
__device__ __forceinline__ unsigned xb_add(unsigned* p, unsigned v) { return __hip_atomic_fetch_add(p, v, __ATOMIC_RELAXED, __HIP_MEMORY_SCOPE_AGENT); }
__device__ __forceinline__ unsigned xb_xcc_id() { return (unsigned)__builtin_amdgcn_s_getreg((3 << 11) | 20) & 0xFu; }
#define XB_SPIN(cond, bar) do { unsigned _sp = 0; while (cond) { __builtin_amdgcn_s_sleep(1); \
    if ((++_sp & 255u) == 0u) { if (xb_ld(&(bar)[XB_TMO])) break; if (_sp > XB_SPIN_CAP) { atomicAdd(&(bar)[XB_TMO], 1u); break; } } } } while (0)
struct XcdBarrier { unsigned* bar; unsigned x; volatile LAS unsigned* st; };
__device__ __forceinline__ void xcd_barrier_complete(unsigned* bar, unsigned x, unsigned& nloc, unsigned& nx) {
    const unsigned G = gridDim.x * gridDim.y * gridDim.z;
    unsigned sum, cnt, mine, sp = 0u;
    for (;;) {
        sum = 0u; cnt = 0u; mine = 0u;
#pragma unroll
        for (unsigned j = 0; j < 16; ++j) { const unsigned c = xb_ld(&bar[XB_XCNT(j)]); sum += c; cnt += (c > 0u) ? 1u : 0u; mine = (j == x) ? c : mine; }
        if (sum == G) break;
        __builtin_amdgcn_s_sleep(1);
        if ((++sp & 255u) == 0u) { if (xb_ld(&bar[XB_TMO])) break; if (sp > XB_SPIN_CAP) { atomicAdd(&bar[XB_TMO], 1u); break; } }
    }
    nloc = mine > 0u ? mine : 1u; nx = cnt > 0u ? cnt : 1u;
}
__device__ __forceinline__ void xcd_barrier(const XcdBarrier& b) {
    asm volatile("s_waitcnt vmcnt(0)" ::: "memory");
    __syncthreads();
    if (threadIdx.x == 0) {
        unsigned* bar = b.bar;
        __builtin_amdgcn_s_waitcnt(0);
        unsigned nloc = b.st[0], nx = b.st[1];
        if (nloc == 0u) { xcd_barrier_complete(bar, b.x, nloc, nx); b.st[0] = nloc; b.st[1] = nx; }
        const unsigned old = xb_add(&bar[XB_XSUB(b.x)], 1u);
        const unsigned gen = old / nloc;
        if (old + 1u == (gen + 1u) * nloc) {
            __builtin_amdgcn_fence(__ATOMIC_RELEASE, "agent");
            asm volatile("s_waitcnt vmcnt(0)" ::: "memory");
            const unsigned og = xb_add(&bar[XB_TOP], 1u);
            const unsigned tg = og / nx;
            if (og + 1u == (tg + 1u) * nx) xb_add(&bar[XB_TOPGEN], 1u);
            else XB_SPIN(xb_ld(&bar[XB_TOPGEN]) == tg, bar);
            __builtin_amdgcn_fence(__ATOMIC_ACQUIRE, "agent");
            xb_add(&bar[XB_XGEN(b.x)], 1u);
            asm volatile("s_waitcnt vmcnt(0)" ::: "memory");
        } else {
            XB_SPIN(xb_ld(&bar[XB_XGEN(b.x)]) == gen, bar);
            __builtin_amdgcn_fence(__ATOMIC_ACQUIRE, "agent");
            asm volatile("s_waitcnt vmcnt(0)" ::: "memory");
        }
    }
    __syncthreads();
}

__global__ void __launch_bounds__(512, 2) mk_fwd(Args a) {
    extern __shared__ __attribute__((aligned(16))) unsigned char lds_raw[];
    cg::grid_group grid = cg::this_grid();
    const int tid0 = threadIdx.x;
    volatile LAS unsigned* xst = (volatile LAS unsigned*)((LAS unsigned char*)lds_raw + (LDS_BYTES - 64));
    if (tid0 < 16) xst[tid0] = 0u;
    __syncthreads();
    XcdBarrier xbar; xbar.bar = (unsigned*)a.ws; xbar.x = xb_xcc_id(); xbar.st = xst;
    if (MK_SINGLE && tid0 == 0) (void)xb_add(&xbar.bar[XB_XCNT(xbar.x)], 1u);
    for (int ph = a.ph_lo; ph < a.ph_hi; ++ph) {
        int tid = tid0; asm volatile("" : "+v"(tid));
        size_t zo = 0; asm volatile("" : "+s"(zo));
        int G = gridDim.x; asm volatile("" : "+s"(G));
        int bx = blockIdx.x; asm volatile("" : "+s"(bx));
        LAS unsigned char* lds = (LAS unsigned char*)lds_raw + zo;
        const int lane = tid & 63, wave = rfl(tid >> 6);
        const int vcu = (G % 8 == 0) ? (bx % 8) * (G / 8) + bx / 8 : bx;
        unsigned char* ws = a.ws + zo;
        ss_t* SS = (ss_t*)(ws + WS_SS);
        float* X = a.out + zo;
        bf16_t* XB = (bf16_t*)(ws + WS_XB);
        const float* ng = (const float*)a.in[3] + zo;
#define AIN(k) ((const float*)a.in[k] + zo)
        if (ph == 0) {
            if (EN & 512) p0_prologue(a, lds, tid, lane, wave, G, bx, zo);
        } else {
            const int i = (ph - 1) / NSUB, s = (ph - 1) % NSUB, j = i >> 1; const bool even = (i & 1) == 0;
            unsigned char* wl = ws + WS_W + (size_t)i * LW_STRIDE;
            unsigned char* we = ws + WS_WE + (size_t)j * WE_STRIDE;
            unsigned char* wo = ws + WS_WO + (size_t)j * WO_STRIDE;
            ss_t* ssb = SS + (size_t)i * 7 * M;
            if (s == 3 && even) {
                const bf16_t* Z = (const bf16_t*)(ws + WS_Z);
                if (EN & 1) for (int rep = 0; rep < 1 + PROBE_HGRN; ++rep) for (int u_ = bx; u_ < 256; u_ += G) hgrn_unit(lds, (G == 256) ? (((u_ & 7) * 4 + (u_ >> 6)) * 8 + ((u_ >> 3) & 7)) : u_, Z,     (const float*)(ws + WS_LF), (bf16_t*)(ws + WS_OH), tid, lane, wave);
                if (EN & 2) for (int u = bx; u < 2048; u += G) gmlp_unit(lds, (G == 256) ? ((32 * (u & 7) + (((u & 255) >> 6) * 8) + (u >> 8)) * 8 + (((u & 255) >> 3) & 7)) : u, Z, AIN(11) + (size_t)j * 8 * 128 * 128, AIN(12) + j * 8 * 128, AIN(10) + j * 512, (bf16_t*)(ws + WS_MIX), tid, (G & 7) != 0 || u == bx);
            } else if (s == 4 && even) {
                hgrn_onorm((const bf16_t*)(ws + WS_OH), (const bf16_t*)(ws + WS_Z), AIN(14) + j * 128, (bf16_t*)(ws + WS_MIX), lane, wave, G);
            } else if (s == 4 && !even) {
                if (EN & 4) for (int u_ = bx; u_ < 512; u_ += G) mla_prep_unit(lds, (G == 256) ? (64 * (u_ & 7) + ((u_ & 255) >> 3) + 32 * (u_ >> 8)) : u_, (bf16_t*)(ws + WS_Q), (bf16_t*)(ws + WS_KV), (const bf16_t*)(ws + WS_ZC), (bf16_t*)(ws + WS_VT), (const int*)AIN(2), AIN(21) + j * 192, AIN(22) + j * 192, tid, lane, wave);
            } else if (s == 5 && !even && !(EN & 8)) {
                const bf16_t* Qp = (const bf16_t*)(ws + WS_Q); const bf16_t* Kp = (const bf16_t*)(ws + WS_KV); bf16_t* Ap = (bf16_t*)(ws + WS_AO);
                for (size_t idx = (size_t)bx * 512 + tid; idx < (size_t)M * 128; idx += (size_t)G * 512) {
                    const size_t row = idx >> 7, c8 = (idx & 127) * 8;
                    float qv[8], kv[8], q2[8], k2[8], vt[8]; unpack8(*(const u32x4*)(Qp + row * 1536 + c8), qv); unpack8(*(const u32x4*)(Kp + row * 1536 + c8), kv);
                    unpack8(*(const u32x4*)(Qp + row * 1536 + 512 + c8), q2); unpack8(*(const u32x4*)(Kp + row * 1536 + 512 + c8), k2);
                    unpack8(*(const u32x4*)((const bf16_t*)(ws + WS_VT) + row * 1024 + c8), vt);
#pragma unroll
                    for (int e = 0; e < 8; ++e) qv[e] = 0.5f * (STQ * (qv[e] + q2[e]) + STK * (kv[e] + k2[e]) + STV * vt[e]);
                    *(u32x4*)(Ap + row * 1024 + c8) = pack8(qv);
                }
            } else if (s == 5 && !even) {
                if (EN & 8) for (int rep = 0; rep < 1 + PROBE_ATT; ++rep) for (int v = vcu; v < 256; v += G) {
                    const int bh = v >> 2, sx = v & 3;
#pragma unroll 1
                    for (int k = 0; k < 4; ++k) { const int qb = (k == 0) ? 15 - sx : (k == 1) ? 8 + sx : (k == 2) ? 7 - sx : sx;
                        attn_unit(lds, bh, qb, (const bf16_t*)(ws + WS_Q), (const bf16_t*)(ws + WS_KV), (const bf16_t*)(ws + WS_VT), (bf16_t*)(ws + WS_AO), lane, wave); }
                }
                __syncthreads();
            } else if (s == 7) {
                p_convert(AIN(1) + (size_t)i * M * 256, (bf16_t*)(ws + WS_PB), tid, G);
            } else if (s == 10) {
                ple_finalize(i == DEPTH - 1 ? X : (float*)nullptr, (const bf16_t*)(ws + WS_TBUF), ssb + 4 * M, ng + (i * 5 + 4) * 1024, XB, SS + (size_t)(i + 1) * 7 * M, lane, wave, G);
            }
            __syncthreads();
            if (s == 0 || s == 7) {
                pg8::EpiUp E{(bf16_t*)(ws + WS_ACT), ssb + (s ? 2 : 0) * M};
                if (EN & 16) pg8::gemm_phase<2 * DFF, DM, DM, DM>(lds, XB, (const bf16_t*)(wl + (s ? OFF_WUP1 : OFF_WUP0)), G, tid, E);
            } else if (s == 1 || s == 8) {
                pg8::EpiResid E{XB, ssb + (s == 8 ? 3 : 1) * M, 0.5f};
                if (EN & 32) pg8::gemm_phase<DM, DFF, DFF, DFF>(lds, (const bf16_t*)(ws + WS_ACT), (const bf16_t*)(wl + (s == 8 ? OFF_WDN1 : OFF_WDN0)), G, tid, E);
                if (s == 8) {
                    __syncthreads();
                    pg8::EpiScale E2{(bf16_t*)(ws + WS_PBUF), DM, nullptr, 0.f, nullptr, nullptr, 0};
                    if (EN & 64) pg8::gemm_phase<DM, 256, 256, 256>(lds, (const bf16_t*)(ws + WS_PB), (const bf16_t*)(wl + OFF_WPP), G, tid, E2);
                }
            } else if (s == 2 && even) {
                pg8::EpiEvenIn E{(bf16_t*)(ws + WS_Z), (float*)(ws + WS_LF), ssb + 1 * M, (const float*)(ws + WS_LB) + j * 512};
                if (EN & 128) pg8::gemm_phase<3072, DM, DM, DM>(lds, XB, (const bf16_t*)(we + OFF_WEIN), G, tid, E);
            } else if (s == 2) {
                pg8::EpiScale E{(bf16_t*)(ws + WS_ZC), 768, ssb + 1 * M, 1.f / 1024.f, nullptr, nullptr, 0};
                if (EN & 64) pg8::gemm_phase<768, DM, DM, DM>(lds, XB, (const bf16_t*)(wo + OFF_WMIN), G, tid, E);
            } else if (s == 3 && !even) {
                pg8::EpiScale E{(bf16_t*)(ws + WS_Q), 1536, nullptr, 0.f, nullptr, nullptr, 0};
                if (EN & 64) pg8::gemm_phase<1536, 384, 768, 384>(lds, (const bf16_t*)(ws + WS_ZC), (const bf16_t*)(wo + OFF_WQB), G, tid, E);
                __syncthreads();
                pg8::EpiKV E2{(bf16_t*)(ws + WS_KV), (bf16_t*)(ws + WS_VT), ssb + 6 * M};
                if (EN & 64) pg8::gemm_phase<2048, 256, 768, 256>(lds, (const bf16_t*)(ws + WS_ZC) + 384, (const bf16_t*)(wo + OFF_WKVB), G, tid, E2);
            } else if (s == 6) {
                pg8::EpiResid E{XB, ssb + 2 * M, 1.0f};
                if (EN & 32) pg8::gemm_phase<DM, DM, DM, DM>(lds, (const bf16_t*)(ws + (even ? WS_MIX : WS_AO)), (const bf16_t*)(even ? we + OFF_WEOUT : wo + OFF_WMOUT), G, tid, E);
            } else if (s == 9) {
                pg8::EpiPleG E{(const bf16_t*)(ws + WS_PBUF), (bf16_t*)(ws + WS_TBUF), ssb + 3 * M, ssb + 4 * M};
                if (EN & 256) pg8::gemm_phase<DM, DM, DM, DM>(lds, XB, (const bf16_t*)(wl + OFF_WPG), G, tid, E);
            }
        }
        if (ph + 1 < a.ph_hi) {
            if (ph >= 1 && ((ph - 1) % NSUB) == 5 && ((((ph - 1) / NSUB) & 1) == 0)) continue;
            if (ph == 0) grid.sync(); else xcd_barrier(xbar);
            if (PROBE_SYNC) xcd_barrier(xbar);
        }
    }
}

extern "C" void kernel_launch(void* const* d_in, const int* in_sizes, int n_in, void* d_out, int out_size, void* d_ws, size_t ws_size, hipStream_t stream) {
    static int grid = 0;
    if (grid == 0) {
        if (n_in != 24 || out_size != M * DM || ws_size < WS_END) { fprintf(stderr, "kernel_launch: unexpected problem (n_in %d out %d ws %zu)\n", n_in, out_size, ws_size); grid = -1; return; }
        int dev = 0, cus = 0, per_cu = 0;
        hipGetDevice(&dev); hipDeviceGetAttribute(&cus, hipDeviceAttributeMultiprocessorCount, dev);
        hipFuncSetAttribute((const void*)mk_fwd, hipFuncAttributeMaxDynamicSharedMemorySize, LDS_BYTES);
        if (hipOccupancyMaxActiveBlocksPerMultiprocessor(&per_cu, (const void*)mk_fwd, 512, LDS_BYTES) != hipSuccess || per_cu < 1) { fprintf(stderr, "kernel_launch: occupancy query says %d\n", per_cu); per_cu = 1; }
        (void)hipGetLastError();
        grid = cus;
    }
    if (grid < 0) return;
    Args a{};
    for (int i = 0; i < 24; ++i) a.in[i] = d_in[i];
    a.out = (float*)d_out; a.ws = (unsigned char*)d_ws;
#if MK_SINGLE
    (void)hipMemsetAsync(d_ws, 0, 16384, stream);
    a.ph_lo = 0; a.ph_hi = NPH;
    void* args[] = {&a};
    hipError_t e = hipLaunchCooperativeKernel((const void*)mk_fwd, dim3(grid), dim3(512), args, LDS_BYTES, stream);
    if (e != hipSuccess) fprintf(stderr, "cooperative launch failed: %s (grid %d)\n", hipGetErrorString(e), grid);
#else
    for (int ph = 0; ph < NPH; ++ph) {
        a.ph_lo = ph; a.ph_hi = ph + 1;
        hipLaunchKernelGGL(mk_fwd, dim3(grid), dim3(512), LDS_BYTES, stream, a);
    }
#endif
}
```
